# Optimizing an MI355X kernel written in HIP

```python
import math
import jax, jax.numpy as jnp
from jax import lax
import numpy as np

D_MODEL = 1024
BATCH = 16
SEQ = 2048
DEPTH = 4
DEC_BATCH = 8
DEC_SEQ = 2048
PAST_LEN = 128

HEAD_DIM = 64
N_MIXERS = 3
A_HEADS = 16
A_KV_HEADS = 4
A_RADIUS = 128
B_CHUNK = 128
B_HIDDEN = 2 * D_MODEL
B_GROUPS = 8
C_GROUPS = ((128, 1), (512, 4), (2048, 16))
C_HEADS = 16
C_KV_HEADS = 4
D_FF = 4 * D_MODEL
NUM_BUCKETS = 32
REL_MAX_DISTANCE = 1024
BIAS_HEADS = 16
RMS_EPS = 1e-6
LN_EPS = 1e-5
N_A = len(range(0, DEPTH, N_MIXERS))
N_B = len(range(1, DEPTH, N_MIXERS))
N_C = len(range(2, DEPTH, N_MIXERS))
A_QKV = (A_HEADS + 2 * A_KV_HEADS) * HEAD_DIM
C_GROUP_QKV = (C_HEADS + 2 * C_KV_HEADS) * HEAD_DIM
C_QKV = len(C_GROUPS) * C_GROUP_QKV

kernel_name = "hybrid_bidir_encoder_window_gmlp_dilated"


def rmsnorm(x, g):
    xf = x.astype(jnp.float32)
    y = xf * lax.rsqrt(jnp.mean(xf * xf, axis=-1, keepdims=True) + RMS_EPS)
    return (y * g.astype(jnp.float32)).astype(x.dtype)


def _rel_bucket(rel):
    half = NUM_BUCKETS // 2
    max_exact = half // 2
    n = np.abs(rel)
    large = max_exact + (np.log(np.maximum(n, 1) / max_exact) / np.log(REL_MAX_DISTANCE / max_exact) * (half - max_exact)).astype(np.int32)
    large = np.minimum(large, half - 1)
    return (rel > 0).astype(np.int32) * half + np.where(n < max_exact, n, large)


def _band_bias(rel_bias, blk, radius, dilation):
    width = blk + 2 * radius
    rel = (np.arange(width)[None, :] - radius - np.arange(blk)[:, None]) * dilation
    return jnp.transpose(rel_bias[_rel_bucket(rel)], (2, 0, 1))


def banded_attention(q, k, v, bias, radius, sink=None):
    n, L, hq, hd = q.shape
    hkv = k.shape[2]
    rep = hq // hkv
    blk = math.gcd(radius, L)
    nb = L // blk
    width = blk + 2 * radius
    idx = np.arange(nb)[:, None] * blk + np.arange(width)[None, :]
    key_pos = idx - radius
    rel = np.arange(width)[None, :] - radius - np.arange(blk)[:, None]
    mask = ((key_pos >= 0) & (key_pos < L))[:, None, :] & (np.abs(rel) <= radius)[None]
    pad = ((0, 0), (radius, radius), (0, 0), (0, 0))
    kb = jnp.take(jnp.pad(k, pad), idx.reshape(-1), axis=1).reshape(n, nb, width, hkv, hd)
    vb = jnp.take(jnp.pad(v, pad), idx.reshape(-1), axis=1).reshape(n, nb, width, hkv, hd)
    qb = q.reshape(n, nb, blk, hkv, rep, hd)
    s = jnp.einsum('bnqgrd,bnkgd->bngrqk', qb, kb, preferred_element_type=jnp.float32) * (hd ** -0.5)
    s = s + bias.reshape(hkv, rep, blk, width).astype(jnp.float32)
    s = jnp.where(mask[None, :, None, None], s, -jnp.inf)
    m = jnp.max(s, axis=-1, keepdims=True)
    if sink is not None:
        sk = sink.reshape(hkv, rep, 1, 1).astype(jnp.float32)
        m = jnp.maximum(m, sk)
    p = jnp.exp(s - m)
    denom = jnp.sum(p, axis=-1, keepdims=True)
    if sink is not None:
        denom = denom + jnp.exp(sk - m)
    o = jnp.einsum('bngrqk,bnkgd->bngrqd', p.astype(v.dtype), vb, preferred_element_type=jnp.float32) / denom
    o = jnp.transpose(o, (0, 1, 4, 2, 3, 5)).reshape(n, L, hq, hd).astype(q.dtype)
    lse = jnp.transpose((m + jnp.log(denom))[..., 0], (0, 1, 4, 2, 3)).reshape(n, L, hq)
    return o, lse


def windowed_sink_gqa(h, w_qkv, sink, w_o, rel_bias):
    B, S, _ = h.shape
    q, k, v = jnp.split(h @ w_qkv, [A_HEADS * HEAD_DIM, (A_HEADS + A_KV_HEADS) * HEAD_DIM], axis=-1)
    q = q.reshape(B, S, A_HEADS, HEAD_DIM)
    k = k.reshape(B, S, A_KV_HEADS, HEAD_DIM)
    v = v.reshape(B, S, A_KV_HEADS, HEAD_DIM)
    bias = _band_bias(rel_bias, math.gcd(A_RADIUS, S), A_RADIUS, 1)
    o, _ = banded_attention(q, k, v, bias, A_RADIUS, sink)
    return o.reshape(B, S, A_HEADS * HEAD_DIM) @ w_o


def spatial_gating_mlp(h, w_in, ln_g, ln_b, w_s, b_s, w_out):
    B, S, _ = h.shape
    z = jax.nn.gelu(h @ w_in, approximate=False)
    u, v = jnp.split(z, 2, axis=-1)
    vf = v.astype(jnp.float32)
    mu = jnp.mean(vf, axis=-1, keepdims=True)
    var = jnp.mean(jnp.square(vf - mu), axis=-1, keepdims=True)
    v = ((vf - mu) * lax.rsqrt(var + LN_EPS) * ln_g.astype(jnp.float32) + ln_b.astype(jnp.float32)).astype(h.dtype)
    vc = v.reshape(B, S // B_CHUNK, B_CHUNK, B_GROUPS, B_HIDDEN // B_GROUPS)
    mixed = jnp.einsum('gpq,bcqge->bcpge', w_s, vc) + jnp.transpose(b_s)[:, :, None]
    return (u * mixed.reshape(B, S, B_HIDDEN)) @ w_out


def dilated_mixture_attention(h, w_qkv, w_o, rel_bias):
    B, S, _ = h.shape
    groups = jnp.split(h @ w_qkv, len(C_GROUPS), axis=-1)
    outs, lses = [], []
    for (window, dil), pg in zip(C_GROUPS, groups):
        q, k, v = jnp.split(pg, [C_HEADS * HEAD_DIM, (C_HEADS + C_KV_HEADS) * HEAD_DIM], axis=-1)
        radius = window // (2 * dil)
        L = S // dil

        def to_sub(t, heads):
            t = t.reshape(B, L, dil, heads, HEAD_DIM)
            return jnp.transpose(t, (0, 2, 1, 3, 4)).reshape(B * dil, L, heads, HEAD_DIM)

        bias = _band_bias(rel_bias, math.gcd(radius, L), radius, dil)
        o, lse = banded_attention(to_sub(q, C_HEADS), to_sub(k, C_KV_HEADS), to_sub(v, C_KV_HEADS), bias, radius)
        outs.append(jnp.transpose(o.reshape(B, dil, L, C_HEADS, HEAD_DIM), (0, 2, 1, 3, 4)).reshape(B, S, C_HEADS, HEAD_DIM))
        lses.append(jnp.transpose(lse.reshape(B, dil, L, C_HEADS), (0, 2, 1, 3)).reshape(B, S, C_HEADS))
    wts = jax.nn.softmax(jnp.stack(lses, axis=0), axis=0)
    o = jnp.einsum('gbsh,gbshd->bshd', wts, jnp.stack(outs, axis=0).astype(jnp.float32)).astype(h.dtype)
    return o.reshape(B, S, C_HEADS * HEAD_DIM) @ w_o


def squared_relu_mlp(h, w1, w2):
    return jnp.square(jax.nn.relu(h @ w1)) @ w2


def trunk(x, rel_bias, norm_mix_g, norm_ffn_g, final_g, ffn_w1, ffn_w2, a_wqkv, a_sink, a_wo,
          b_win, b_ln_g, b_ln_b, b_ws, b_bs, b_wo, c_wqkv, c_wo):
    for i in range(DEPTH):
        kind, j = i % N_MIXERS, i // N_MIXERS
        h = rmsnorm(x, norm_mix_g[i])
        if kind == 0:
            m = windowed_sink_gqa(h, a_wqkv[j], a_sink[j], a_wo[j], rel_bias)
        elif kind == 1:
            m = spatial_gating_mlp(h, b_win[j], b_ln_g[j], b_ln_b[j], b_ws[j], b_bs[j], b_wo[j])
        else:
            m = dilated_mixture_attention(h, c_wqkv[j], c_wo[j], rel_bias)
        x = x + m
        x = x + squared_relu_mlp(rmsnorm(x, norm_ffn_g[i]), ffn_w1[i], ffn_w2[i])
    return rmsnorm(x, final_g)


def setup_inputs(seed: int = 0) -> dict:
    key = jax.random.key(seed)
    ks = jax.random.split(key, 20)

    def nrm(k, shape, scale):
        return jax.random.normal(k, shape, jnp.float32) * scale

    return {
        "x_prompt": nrm(ks[0], (BATCH, SEQ, D_MODEL), 1.0),
        "x_sample": nrm(ks[1], (DEC_BATCH, DEC_SEQ, D_MODEL), 1.0),
        "rel_bias": nrm(ks[2], (NUM_BUCKETS, BIAS_HEADS), 0.5),
        "norm_mix_g": 1.0 + nrm(ks[3], (DEPTH, D_MODEL), 0.05),
        "norm_ffn_g": 1.0 + nrm(ks[4], (DEPTH, D_MODEL), 0.05),
        "final_g": 1.0 + nrm(ks[5], (D_MODEL,), 0.05),
        "ffn_w1": nrm(ks[6], (DEPTH, D_MODEL, D_FF), D_MODEL ** -0.5),
        "ffn_w2": nrm(ks[7], (DEPTH, D_FF, D_MODEL), 0.5 * D_FF ** -0.5),
        "a_wqkv": nrm(ks[8], (N_A, D_MODEL, A_QKV), D_MODEL ** -0.5),
        "a_sink": nrm(ks[9], (N_A, A_HEADS), 0.5),
        "a_wo": nrm(ks[10], (N_A, A_HEADS * HEAD_DIM, D_MODEL), (A_HEADS * HEAD_DIM) ** -0.5),
        "b_win": nrm(ks[11], (N_B, D_MODEL, 2 * B_HIDDEN), D_MODEL ** -0.5),
        "b_ln_g": 1.0 + nrm(ks[12], (N_B, B_HIDDEN), 0.05),
        "b_ln_b": nrm(ks[13], (N_B, B_HIDDEN), 0.02),
        "b_ws": nrm(ks[14], (N_B, B_GROUPS, B_CHUNK, B_CHUNK), B_CHUNK ** -0.5),
        "b_bs": 1.0 + nrm(ks[15], (N_B, B_GROUPS, B_CHUNK), 0.1),
        "b_wo": nrm(ks[16], (N_B, B_HIDDEN, D_MODEL), B_HIDDEN ** -0.5),
        "c_wqkv": nrm(ks[17], (N_C, D_MODEL, C_QKV), D_MODEL ** -0.5),
        "c_wo": nrm(ks[18], (N_C, C_HEADS * HEAD_DIM, D_MODEL), (C_HEADS * HEAD_DIM) ** -0.5),
    }


def reference(x_prompt, x_sample, rel_bias, norm_mix_g, norm_ffn_g, final_g, ffn_w1, ffn_w2,
              a_wqkv, a_sink, a_wo, b_win, b_ln_g, b_ln_b, b_ws, b_bs, b_wo, c_wqkv, c_wo):
    y_prompt = trunk(x_prompt, rel_bias, norm_mix_g, norm_ffn_g, final_g, ffn_w1, ffn_w2, a_wqkv, a_sink, a_wo,
                     b_win, b_ln_g, b_ln_b, b_ws, b_bs, b_wo, c_wqkv, c_wo)
    y_sample = trunk(x_sample, rel_bias, norm_mix_g, norm_ffn_g, final_g, ffn_w1, ffn_w2, a_wqkv, a_sink, a_wo,
                     b_win, b_ln_g, b_ln_b, b_ws, b_bs, b_wo, c_wqkv, c_wo)
    return (y_prompt, y_sample)
```

```cpp
#include <hip/hip_runtime.h>
#include <hip/hip_cooperative_groups.h>
#include <cstdio>
#include <cstring>
namespace cg = cooperative_groups;

#ifndef NAIVE_ATTN
#define NAIVE_ATTN 0
#endif
#ifndef NAIVE_MIX
#define NAIVE_MIX 0
#endif
#ifndef PROBE_TYPE
#define PROBE_TYPE 0
#endif
#ifndef PROBE_REP
#define PROBE_REP 0
#endif
#ifndef ONE_LAUNCH
#define ONE_LAUNCH 1
#endif

#define LAS __attribute__((address_space(3)))
typedef unsigned short bf16_t;
typedef short bf16x8 __attribute__((ext_vector_type(8)));
typedef float f32x4 __attribute__((ext_vector_type(4)));
typedef float f32x2 __attribute__((ext_vector_type(2)));
typedef unsigned u32x4 __attribute__((ext_vector_type(4)));
typedef unsigned u32x2 __attribute__((ext_vector_type(2)));

constexpr int T_TOK = 49152, DM = 1024, SEQ = 2048, CHK = 16384, NCHK = 3;
constexpr int LDS_BYTES = 131072 + 16 + 4096 + 16384 + 8192;
constexpr size_t OFF_W1 = 0, OFF_W2 = 16777216, OFF_AQKV = 33554432, OFF_AWO = 36700160, OFF_BWIN = 38797312, OFF_BWO = 42991616,
                 OFF_CQKV = 45088768, OFF_CWO = 49807360, OFF_BWS = 50855936, WT_END = 50987008;
constexpr size_t WS_WT = 0, WS_P = 104857600, WS_H = WS_P + (size_t)T_TOK * DM * 2, WS_S = WS_H + (size_t)T_TOK * DM * 2, WS_NEED = 536870912;
constexpr size_t WS_SSQ0 = 0, WS_SSQ1 = 0;
constexpr size_t S_OG = 150994944, S_LSE = S_OG + 2 * (size_t)CHK * 1024 * 2;
constexpr size_t WS_BAR = 102236160;
constexpr size_t S_SSQ0 = 224395264, S_SSQ1 = S_SSQ0 + (size_t)T_TOK * 64;
static_assert(WS_S + S_SSQ1 + (size_t)T_TOK * 64 <= WS_NEED && S_SSQ0 >= S_LSE + 3 * (size_t)CHK * 64, "ssq buffers");
constexpr size_t S_STATS = 134217728;
constexpr size_t S_GATE = 142606336;

enum { PH_PREP = 1, PH_A_QKV, PH_A_ATTN, PH_A_WO, PH_NORM_FFN, PH_FFN1, PH_FFN2, PH_NORM_MIX, PH_B_IN, PH_B_STATS, PH_B_MIX, PH_B_OUT, PH_C_QKV, PH_C_ATTN, PH_C_WO, PH_FINAL, PH_C_MERGE };
static_assert(WS_S + S_LSE + 3 * (size_t)CHK * 16 * 4 <= WS_NEED, "workspace");

struct Params {
    const float* x_prompt; const float* x_sample; const float* rel_bias; const float* norm_mix_g; const float* norm_ffn_g; const float* final_g;
    const float* ffn_w1; const float* ffn_w2; const float* a_wqkv; const float* a_sink; const float* a_wo;
    const float* b_win; const float* b_ln_g; const float* b_ln_b; const float* b_ws; const float* b_bs; const float* b_wo;
    const float* c_wqkv; const float* c_wo;
    float* X; unsigned char* ws;
};

__device__ __forceinline__ bf16_t f2bf(float f) { unsigned u = __float_as_uint(f); u += 0x7FFFu + ((u >> 16) & 1u); return (bf16_t)(u >> 16); }
__device__ __forceinline__ float bf2f(bf16_t b) { return __uint_as_float(((unsigned)b) << 16); }
__device__ __forceinline__ float bflo(unsigned w) { return __uint_as_float(w << 16); }
__device__ __forceinline__ float bfhi(unsigned w) { return __uint_as_float(w & 0xffff0000u); }
__device__ __forceinline__ unsigned pack2(float lo, float hi) { return (unsigned)f2bf(lo) | ((unsigned)f2bf(hi) << 16); }
__device__ __forceinline__ float wave_sum(float v) { for (int o = 32; o > 0; o >>= 1) v += __shfl_xor(v, o, 64); return v; }
__device__ __forceinline__ float wave_max(float v) { for (int o = 32; o > 0; o >>= 1) v = fmaxf(v, __shfl_xor(v, o, 64)); return v; }
__device__ __forceinline__ int tid_opaque() { int t = threadIdx.x; asm volatile("" : "+v"(t)); return t; }
__device__ __forceinline__ float rdlane(float v, int l) { return __int_as_float(__builtin_amdgcn_readlane(__float_as_int(v), l)); }


#define XB_TMO      128
#define XB_XCNT(j)  (256  + 64 * (j))
#define XB_XSUB(j)  (1280 + 64 * (j))
#define XB_XGEN(j)  (2304 + 64 * (j))
#define XB_TOP      3328
#define XB_TOPGEN   3392
#define XB_LSUB(j)  (3456 + 64 * (j))
#define XB_LGEN(j)  (4480 + 64 * (j))
#define XCD_BAR_WORDS 5504
#define XB_SPIN_CAP (1u << 22)
__device__ __forceinline__ unsigned xb_ld(unsigned* p)              { return __hip_atomic_load(p, __ATOMIC_RELAXED, __HIP_MEMORY_SCOPE_AGENT); }
__device__ __forceinline__ unsigned xb_add(unsigned* p, unsigned v) { return __hip_atomic_fetch_add(p, v, __ATOMIC_RELAXED, __HIP_MEMORY_SCOPE_AGENT); }
__device__ __forceinline__ unsigned xb_xcc_id() { return (unsigned)__builtin_amdgcn_s_getreg((3 << 11) | 20) & 0xFu; }
#define XB_SPIN(cond, bar) do { unsigned _sp = 0; while (cond) { __builtin_amdgcn_s_sleep(1); \
    if ((++_sp & 255u) == 0u) { if (xb_ld(&(bar)[XB_TMO])) break; if (_sp > XB_SPIN_CAP) { atomicAdd(&(bar)[XB_TMO], 1u); break; } } } } while (0)
struct XcdBarrier { unsigned* bar; unsigned x; volatile LAS unsigned* st; };
__device__ __forceinline__ XcdBarrier xcd_barrier_post(unsigned* bar, volatile LAS unsigned* st) {
    XcdBarrier b; b.bar = bar; b.x = xb_xcc_id(); b.st = st;
    if (threadIdx.x == 0) { const unsigned rho = blockIdx.x & 7u; (void)xb_add(&bar[XB_XCNT(b.x)], 1u | (rho << 9) | ((rho * rho) << 20)); }
    return b;
}
__device__ __forceinline__ void xcd_barrier_complete(unsigned* bar, unsigned x, unsigned& nloc, unsigned& nx, bool& rr) {
    const unsigned G = gridDim.x * gridDim.y * gridDim.z;
    unsigned sum, cnt, mine, mism, even, sp = 0u;
    for (;;) {
        sum = 0u; cnt = 0u; mine = 0u; mism = 0u; even = 1u;
#pragma unroll
        for (unsigned j = 0; j < 16; ++j) { const unsigned w = xb_ld(&bar[XB_XCNT(j)]); const unsigned c = w & 0x1ffu, sr = (w >> 9) & 0x7ffu, sq = w >> 20; sum += c; cnt += (c > 0u) ? 1u : 0u; mine = (j == x) ? c : mine;
            mism += (c * sq != sr * sr) ? 1u : 0u;
            even &= (j < 8u ? c == (G >> 3) : w == 0u) ? 1u : 0u; }
        if (sum == G) break;
        __builtin_amdgcn_s_sleep(1);
        if ((++sp & 255u) == 0u) { if (xb_ld(&bar[XB_TMO])) break; if (sp > XB_SPIN_CAP) { atomicAdd(&bar[XB_TMO], 1u); break; } }
    }
    nloc = mine > 0u ? mine : 1u; nx = cnt > 0u ? cnt : 1u;
    rr = (sum == G) && (mism == 0u) && (even != 0u) && (G == 256u);
}
__device__ __forceinline__ void xcd_barrier(const XcdBarrier& b) {
    asm volatile("s_waitcnt vmcnt(0)" ::: "memory");
    __syncthreads();
    if (threadIdx.x == 0) {
        unsigned* bar = b.bar;
        __builtin_amdgcn_s_waitcnt(0);
        unsigned nloc = b.st[0], nx = b.st[1];
        if (nloc == 0u) { bool rr = false; xcd_barrier_complete(bar, b.x, nloc, nx, rr); b.st[0] = nloc; b.st[1] = nx; b.st[3] = rr ? 1u : 0u; }
        const unsigned old = xb_add(&bar[XB_XSUB(b.x)], 1u);
        const unsigned gen = old / nloc;
        if (old + 1u == (gen + 1u) * nloc) {
            __builtin_amdgcn_fence(__ATOMIC_RELEASE, "agent");
            asm volatile("s_waitcnt vmcnt(0)" ::: "memory");
            const unsigned og = xb_add(&bar[XB_TOP], 1u);
            const unsigned tg = og / nx;
            if (og + 1u == (tg + 1u) * nx) xb_add(&bar[XB_TOPGEN], 1u);
            else XB_SPIN(xb_ld(&bar[XB_TOPGEN]) == tg, bar);
            __builtin_amdgcn_fence(__ATOMIC_ACQUIRE, "agent");
            xb_add(&bar[XB_XGEN(b.x)], 1u);
            asm volatile("s_waitcnt vmcnt(0)" ::: "memory");
        } else {
            XB_SPIN(xb_ld(&bar[XB_XGEN(b.x)]) == gen, bar);
            __builtin_amdgcn_fence(__ATOMIC_ACQUIRE, "agent");
            asm volatile("s_waitcnt vmcnt(0)" ::: "memory");
        }
    }
    __syncthreads();
}

__device__ __forceinline__ void xcd_local_barrier(const XcdBarrier& b) {
    asm volatile("s_waitcnt vmcnt(0)" ::: "memory");
    __syncthreads();
    if (threadIdx.x == 0) {
        unsigned* bar = b.bar;
        __builtin_amdgcn_s_waitcnt(0);
        const unsigned nloc = b.st[0];
        const unsigned old = xb_add(&bar[XB_LSUB(b.x)], 1u);
        const unsigned gen = old / nloc;
        if (old + 1u == (gen + 1u) * nloc) xb_add(&bar[XB_LGEN(b.x)], 1u);
        else XB_SPIN(xb_ld(&bar[XB_LGEN(b.x)]) == gen, bar);
        __builtin_amdgcn_fence(__ATOMIC_ACQUIRE, "agent");
        asm volatile("s_waitcnt vmcnt(0)" ::: "memory");
    }
    __syncthreads();
}

namespace pg8 {
constexpr int BM = 256, BK = 64, HALF = 128, HTB = HALF * BK * 2, STAGE_BYTES = 8 * HTB, NXCD = 8, WGM = 4;
__host__ __device__ __forceinline__ int lds_byte(int r, int c) { const int st = (r >> 4) * 2 + (c >> 5), rr = r & 15, cc = c & 31, ob = rr * 64 + cc * 2; return st * 1024 + (ob ^ (((ob >> 9) & 1) << 5)); }
__host__ __device__ __forceinline__ void stage_rc(int b, int& R, int& C) { const int st = b / 1024, sb = b % 1024, swz = sb ^ (((sb >> 9) & 1) << 5); R = (st >> 1) * 16 + swz / 64; C = (st & 1) * 32 + (swz % 64) / 2; }
__host__ __device__ __forceinline__ int perm32(int rho) { const int n = rho >> 4, i = rho & 15; return 8 * (i >> 2) + 4 * n + (i & 3); }
struct Unit { int pm, pn; };
struct Gemm { const bf16_t* A; const bf16_t* Bt; int M, N, K, lda; };
struct StaticOrder {
    int nM, nN, nwg, G, c; bool permT;
    __device__ void init(int M, int N, int G_, int c_, bool permT_ = false) { nM = M / BM; nN = N / BM; nwg = nM * nN; G = G_; c = c_; permT = permT_ && nM == 192 && nN == 4 && G_ == 256; }
    __device__ bool next(int i, Unit& u) const {
        const long L = (long)i * G + c; if (L >= nwg) return false;
        int wgid = (int)L; { const int q = nwg / NXCD, r = nwg % NXCD, xcd = wgid % NXCD, off = wgid / NXCD; wgid = (xcd < r ? xcd * (q + 1) : r * (q + 1) + (xcd - r) * q) + off; }
        const int nig = WGM * nN, gid = wgid / nig, fm = gid * WGM, gsz = (nM - fm) < WGM ? (nM - fm) : WGM;
        u.pm = fm + ((wgid % nig) % gsz); u.pn = (wgid % nig) / gsz;
        if (permT) { const int x = u.pm / 24, j = u.pm - 24 * x; u.pm = 64 * (j >> 3) + 8 * x + (j & 7); }
        return true;
    }
};
__device__ __forceinline__ unsigned cvt_pk_bf16(float lo, float hi) { unsigned r; asm volatile("v_cvt_pk_bf16_f32 %0, %1, %2" : "=v"(r) : "v"(lo), "v"(hi)); return r; }
__device__ __forceinline__ f32x2 gelu_pk(f32x2 v) {
    const f32x2 av = __builtin_elementwise_abs(v), d = av * 0.2316418882f + 1.0f;
    f32x2 t; t.x = __builtin_amdgcn_rcpf(d.x); t.y = __builtin_amdgcn_rcpf(d.y);
    f32x2 q = t * 0.5307027145f + (-0.7265760135f); q = q * t + 0.7107068705f; q = q * t + (-0.142248368f); q = q * t + 0.127414796f; q = q * t;
    const f32x2 s = (v * v) * (-0.72134752044f);
    f32x2 e; e.x = __builtin_amdgcn_exp2f(s.x); e.y = __builtin_amdgcn_exp2f(s.y);
    const f32x2 m = v * (q * e), r = v - m;
    f32x2 o; o.x = v.x < 0.f ? m.x : r.x; o.y = v.y < 0.f ? m.y : r.y; return o;
}
struct EpiRes {
    static constexpr bool PERM = true;
    bf16_t* Cb; float* ssq; LAS float* red;
    __device__ __forceinline__ void init(f32x4 (&acc)[2][2][4][2], const Unit& u, int wr, int wc, int fr, int fq) const {
        const int row0 = u.pm * BM + wr * 64 + fr, col0 = u.pn * BM + wc * 32 + 8 * fq;
#pragma unroll
        for (int ai = 0; ai < 2; ++ai)
#pragma unroll
            for (int m = 0; m < 4; ++m) { const bf16_t* rowp = Cb + (size_t)(row0 + ai * HALF + m * 16) * DM + col0;
#pragma unroll
                for (int bj = 0; bj < 2; ++bj) { const u32x4 w = *(const u32x4*)(rowp + bj * HALF);
                    acc[ai][bj][m][0] = (f32x4){bflo(w.x), bfhi(w.x), bflo(w.y), bfhi(w.y)}; acc[ai][bj][m][1] = (f32x4){bflo(w.z), bfhi(w.z), bflo(w.w), bfhi(w.w)}; } }
    }
    __device__ __forceinline__ void operator()(const f32x4 (&acc)[2][2][4][2], const Unit& u, int wr, int wc, int fr, int fq) const {
        const int row0 = u.pm * BM + wr * 64 + fr, col0 = u.pn * BM + wc * 32 + 8 * fq;
#pragma unroll
        for (int ai = 0; ai < 2; ++ai)
#pragma unroll
            for (int m = 0; m < 4; ++m) { const int row = row0 + ai * HALF + m * 16; bf16_t* rowb = Cb + (size_t)row * DM + col0; float ss = 0.f;
#pragma unroll
                for (int bj = 0; bj < 2; ++bj) { const f32x4 v0 = acc[ai][bj][m][0], v1 = acc[ai][bj][m][1];
                    u32x4 w; w.x = cvt_pk_bf16(v0[0], v0[1]); w.y = cvt_pk_bf16(v0[2], v0[3]); w.z = cvt_pk_bf16(v1[0], v1[1]); w.w = cvt_pk_bf16(v1[2], v1[3]);
                    *(u32x4*)(rowb + bj * HALF) = w;
                    ss += v0[0] * v0[0] + v0[1] * v0[1] + v0[2] * v0[2] + v0[3] * v0[3] + v1[0] * v1[0] + v1[1] * v1[1] + v1[2] * v1[2] + v1[3] * v1[3]; }
                ss += __shfl_xor(ss, 16, 64); ss += __shfl_xor(ss, 32, 64);
                if (fq == 0) red[(wr * 64 + fr + ai * HALF + m * 16) * 4 + wc] = ss; }
        asm volatile("s_waitcnt lgkmcnt(0)" ::: "memory"); __builtin_amdgcn_s_barrier(); asm volatile("" ::: "memory");
        if (wc == 0 && fq == 0) {
#pragma unroll
            for (int ai = 0; ai < 2; ++ai)
#pragma unroll
                for (int m = 0; m < 4; ++m) { const int rl = wr * 64 + fr + ai * HALF + m * 16; const f32x4 v = *(const LAS f32x4*)(red + rl * 4);
                    ssq[(size_t)(u.pm * BM + rl) * 4 + u.pn] = (v[0] + v[1]) + (v[2] + v[3]); }
        }
    }
};
template <int ACT  > struct EpiBf16 {
    static constexpr bool PERM = true;
    bf16_t* O; int ldc; const float* ssq; LAS float* rsl; float2* stat; LAS float* red2;
    __device__ __forceinline__ void init(f32x4 (&acc)[2][2][4][2], const Unit& u, int wr, int wc, int fr, int fq) const {
        {
            const float* src = ssq + (size_t)(u.pm * BM + wr * 64 + fq * 16 + fr) * 4;
            LAS unsigned char* dst = (LAS unsigned char*)rsl + (wr * 4 + wc) * 2048;
            __builtin_amdgcn_global_load_lds((const unsigned*)src, (LAS unsigned*)dst, 16, 0, 0);
            __builtin_amdgcn_global_load_lds((const unsigned*)(src + HALF * 4), (LAS unsigned*)(dst + 1024), 16, 0, 0);
        }
#pragma unroll
        for (int a = 0; a < 2; ++a)
#pragma unroll
            for (int b = 0; b < 2; ++b)
#pragma unroll
                for (int m = 0; m < 4; ++m)
#pragma unroll
                    for (int n = 0; n < 2; ++n) acc[a][b][m][n] = (f32x4){0.f, 0.f, 0.f, 0.f};
    }
    __device__ __forceinline__ void operator()(const f32x4 (&acc)[2][2][4][2], const Unit& u, int wr, int wc, int fr, int fq) const {
        const int row0 = u.pm * BM + wr * 64 + fr, col0 = u.pn * BM + wc * 32 + 8 * fq;
        const bool dost = (ACT == 1) && u.pn >= 8;
#pragma unroll
        for (int ai = 0; ai < 2; ++ai)
#pragma unroll
            for (int m = 0; m < 4; ++m) { const int row = row0 + ai * HALF + m * 16; bf16_t* rowp = O + (size_t)row * ldc + col0;
                const f32x4 s4 = *(const LAS f32x4*)((const LAS unsigned char*)rsl + (wr * 4 + wc) * 2048 + ai * 1024 + (m * 16 + fr) * 16);
                const float rs = __builtin_amdgcn_rsqf(((s4[0] + s4[1]) + (s4[2] + s4[3])) * (1.0f / 1024.0f) + 1e-6f);
                float s1 = 0.f, s2 = 0.f;
#pragma unroll
                for (int bj = 0; bj < 2; ++bj) { f32x4 v0, v1;
                    if (ACT == 2) { const f32x4 a0 = acc[ai][bj][m][0], a1 = acc[ai][bj][m][1], z4 = (f32x4){0.f, 0.f, 0.f, 0.f}; const float rs2 = rs * rs;
                        v0 = (a0 * __builtin_elementwise_max(a0, z4)) * rs2; v1 = (a1 * __builtin_elementwise_max(a1, z4)) * rs2; }
                    else { v0 = acc[ai][bj][m][0] * rs; v1 = acc[ai][bj][m][1] * rs; }
                    if (ACT == 1) { f32x2 a = gelu_pk((f32x2){v0[0], v0[1]}), b = gelu_pk((f32x2){v0[2], v0[3]}), c = gelu_pk((f32x2){v1[0], v1[1]}), d = gelu_pk((f32x2){v1[2], v1[3]});
                        v0 = (f32x4){a.x, a.y, b.x, b.y}; v1 = (f32x4){c.x, c.y, d.x, d.y};
                        s1 += ((v0[0] + v0[1]) + (v0[2] + v0[3])) + ((v1[0] + v1[1]) + (v1[2] + v1[3]));
                        s2 += ((v0[0] * v0[0] + v0[1] * v0[1]) + (v0[2] * v0[2] + v0[3] * v0[3])) + ((v1[0] * v1[0] + v1[1] * v1[1]) + (v1[2] * v1[2] + v1[3] * v1[3])); }
                    u32x4 w; w.x = cvt_pk_bf16(v0[0], v0[1]); w.y = cvt_pk_bf16(v0[2], v0[3]); w.z = cvt_pk_bf16(v1[0], v1[1]); w.w = cvt_pk_bf16(v1[2], v1[3]);
                    *(u32x4*)(rowp + bj * HALF) = w; }
                if (ACT == 1) { if (dost) { s1 += __shfl_xor(s1, 16, 64); s1 += __shfl_xor(s1, 32, 64); s2 += __shfl_xor(s2, 16, 64); s2 += __shfl_xor(s2, 32, 64);
                    if (fq == 0) { LAS float* rp = red2 + ((wr * 64 + fr + ai * HALF + m * 16) * 4 + wc) * 2; rp[0] = s1; rp[1] = s2; } } } }
        if (ACT == 1) { if (dost) {
            asm volatile("s_waitcnt lgkmcnt(0)" ::: "memory"); __builtin_amdgcn_s_barrier(); asm volatile("" ::: "memory");
            if (wc == 0 && fq == 0) {
#pragma unroll
                for (int ai = 0; ai < 2; ++ai)
#pragma unroll
                    for (int m = 0; m < 4; ++m) { const int rl = wr * 64 + fr + ai * HALF + m * 16; const f32x4 a = *(const LAS f32x4*)(red2 + rl * 8), b = *(const LAS f32x4*)(red2 + rl * 8 + 4);
                        stat[(size_t)(u.pm * BM + rl) * 8 + (u.pn - 8)] = make_float2((a[0] + a[2]) + (b[0] + b[2]), (a[1] + a[3]) + (b[1] + b[3])); }
            } } }
    }
};

template <class Epi>
__device__ __forceinline__ void gemm_phase(LAS unsigned char* lds, const Gemm g, const StaticOrder& S, const Epi& E) {
    const int tid = tid_opaque(), wid = __builtin_amdgcn_readfirstlane(tid >> 6), lane = tid & 63, wr = wid >> 2, wc = wid & 3, fr = lane & 15, fq = lane >> 4;
    const int K = g.K, nt = K / BK, lda = g.lda;
    unsigned voffA[2], voffB[2];
#pragma unroll
    for (int i = 0; i < 2; ++i) { int R, C; stage_rc(tid * 16 + i * 8192, R, C); const int Rb = Epi::PERM ? ((R & ~31) + perm32(R & 31)) : R;
        voffA[i] = (unsigned)(R * lda + C) * 2u; voffB[i] = (unsigned)(Rb * K + C) * 2u; }
    const size_t kstep = (size_t)(BK * 2);
    const size_t hstepA = (size_t)HALF * lda * 2, hstepB = (size_t)HALF * K * 2;
    const size_t tstepA = 2 * hstepA, tstepB = 2 * hstepB;
    const unsigned ldsw = (unsigned)wid * 1024u;
    const int aoff = lds_byte(wr * 64 + fr, fq * 8), boff = lds_byte(wc * 32 + fr, fq * 8);
#define PG8_SA(b, h) (((b) * 2 + (h)) * HTB)
#define PG8_SB(b, h) ((4 + (b) * 2 + (h)) * HTB)
#define PG8_STAGE(bufoff, gbase, voff) do { _Pragma("unroll") for (int _i = 0; _i < 2; ++_i) \
        __builtin_amdgcn_global_load_lds((const unsigned*)((const char*)(gbase) + (voff)[_i]), (LAS unsigned*)(lds + (bufoff) + ldsw + _i * 8192), 16, 0, 0); } while (0)
#define PG8_LDA(dst, b, h) do { _Pragma("unroll") for (int m = 0; m < 4; ++m) _Pragma("unroll") for (int k = 0; k < 2; ++k) dst[m][k] = *(const LAS bf16x8*)(lds + PG8_SA(b, h) + aoff + m * 2048 + k * 1024); } while (0)
#define PG8_LDB(dst, b, h) do { _Pragma("unroll") for (int n = 0; n < 2; ++n) _Pragma("unroll") for (int k = 0; k < 2; ++k) dst[n][k] = *(const LAS bf16x8*)(lds + PG8_SB(b, h) + boff + n * 2048 + k * 1024); } while (0)
#define PG8_MMA(ai, bj, At, Bt) do { __builtin_amdgcn_s_setprio(1); _Pragma("unroll") for (int m = 0; m < 4; ++m) _Pragma("unroll") for (int n = 0; n < 2; ++n) _Pragma("unroll") for (int k = 0; k < 2; ++k) \
        acc[ai][bj][m][n] = __builtin_amdgcn_mfma_f32_16x16x32_bf16(Bt[n][k], At[m][k], acc[ai][bj][m][n], 0, 0, 0); __builtin_amdgcn_s_setprio(0); } while (0)
#define PG8_WAIT_V(n) asm volatile("s_waitcnt vmcnt(" #n ")" ::: "memory")
#define PG8_WAIT_L(n) asm volatile("s_waitcnt lgkmcnt(" #n ")" ::: "memory")
#define PG8_BAR __builtin_amdgcn_s_barrier()
#define PG8_SCHED __builtin_amdgcn_sched_barrier(0)
    Unit cur, nxt; int ui = 0;
    if (!S.next(0, cur)) return;
    f32x4 acc[2][2][4][2];
    E.init(acc, cur, wr, wc, fr, fq);
    bf16x8 At[4][2], B0[2][2], B1[2][2];
    const char* cA = (const char*)g.A + (size_t)cur.pm * tstepA; const char* cB = (const char*)g.Bt + (size_t)cur.pn * tstepB;
    PG8_STAGE(PG8_SB(0, 0), cB, voffB); PG8_STAGE(PG8_SB(0, 1), cB + hstepB, voffB); PG8_STAGE(PG8_SA(0, 0), cA, voffA); PG8_STAGE(PG8_SA(0, 1), cA + hstepA, voffA);
    if (wr == 1) PG8_BAR;
    PG8_WAIT_V(2); PG8_BAR;
    PG8_STAGE(PG8_SB(1, 0), cB + kstep, voffB); PG8_STAGE(PG8_SA(1, 0), cA + kstep, voffA); PG8_STAGE(PG8_SB(1, 1), cB + hstepB + kstep, voffB);
    PG8_WAIT_V(6); PG8_BAR;
    for (;;) {
        const bool has_next = S.next(ui + 1, nxt);
        const char* nA = has_next ? (const char*)g.A + (size_t)nxt.pm * tstepA : cA; const char* nB = has_next ? (const char*)g.Bt + (size_t)nxt.pn * tstepB : cB;
        for (int t = 0; t < nt; t += 2) {
            const bool last = (t == nt - 2);
            const char* a1 = cA + (size_t)(t + 1) * kstep;
            const char* a2 = last ? nA : cA + (size_t)(t + 2) * kstep; const char* b2 = last ? nB : cB + (size_t)(t + 2) * kstep;
            const char* a3 = a2 + kstep; const char* b3 = b2 + kstep;
            PG8_LDB(B0, 0, 0); PG8_LDB(B1, 0, 1); PG8_SCHED; PG8_LDA(At, 0, 0); PG8_STAGE(PG8_SA(1, 1), a1 + hstepA, voffA);
            PG8_WAIT_V(8); PG8_WAIT_L(0); PG8_BAR; PG8_MMA(0, 0, At, B0); PG8_MMA(0, 1, At, B1); PG8_BAR; PG8_SCHED;
            PG8_LDA(At, 0, 1); PG8_STAGE(PG8_SB(0, 0), b2, voffB); PG8_STAGE(PG8_SB(0, 1), b2 + hstepB, voffB); PG8_STAGE(PG8_SA(0, 0), a2, voffA);
            PG8_WAIT_V(8); PG8_WAIT_L(0); PG8_BAR; PG8_MMA(1, 0, At, B0); PG8_MMA(1, 1, At, B1); PG8_BAR; PG8_SCHED;
            PG8_LDB(B0, 1, 0); PG8_LDB(B1, 1, 1); PG8_SCHED; PG8_LDA(At, 1, 0); PG8_STAGE(PG8_SA(0, 1), a2 + hstepA, voffA);
            PG8_WAIT_V(8); PG8_WAIT_L(0); PG8_BAR; PG8_MMA(0, 0, At, B0); PG8_MMA(0, 1, At, B1); PG8_BAR; PG8_SCHED;
            PG8_LDA(At, 1, 1); PG8_STAGE(PG8_SB(1, 0), b3, voffB); PG8_STAGE(PG8_SB(1, 1), b3 + hstepB, voffB); PG8_STAGE(PG8_SA(1, 0), a3, voffA);
            PG8_WAIT_V(8); PG8_WAIT_L(0); PG8_BAR; PG8_MMA(1, 0, At, B0); PG8_MMA(1, 1, At, B1); PG8_BAR; PG8_SCHED;
        }
        if (wr == 0) PG8_BAR;
        E(acc, cur, wr, wc, fr, fq);
        if (!has_next) break;
        E.init(acc, nxt, wr, wc, fr, fq);
        cur = nxt; cA = nA; cB = nB; ++ui;
        if (wr == 1) PG8_BAR;
    }
    PG8_WAIT_V(0);
    PG8_BAR;
#undef PG8_SA
#undef PG8_SB
#undef PG8_STAGE
#undef PG8_LDA
#undef PG8_LDB
#undef PG8_MMA
#undef PG8_WAIT_V
#undef PG8_WAIT_L
#undef PG8_BAR
#undef PG8_SCHED
}
}

__device__ __forceinline__ int rel_bucket(int rel) {
    const int n = rel < 0 ? -rel : rel;
    const int b = n < 8 ? n : (8 + (n >= 15) + (n >= 27) + (n >= 50) + (n >= 91) + (n >= 166) + (n >= 305) + (n >= 559));
    return (rel > 0 ? 16 : 0) + b;
}

__device__ void convert_T(const float* __restrict__ src, bf16_t* __restrict__ dst, int K, int N, float* tile, const float* __restrict__ gk = nullptr) {
    const int tn = N / 64, nt = (K / 64) * tn, tid = tid_opaque();
    for (int t = blockIdx.x; t < nt; t += gridDim.x) {
        const int k0 = (t / tn) * 64, n0 = (t % tn) * 64;
        for (int idx = tid; idx < 1024; idx += 512) {
            const int kk = idx >> 4, n4 = (idx & 15) * 4;
            const float4 v = *(const float4*)(src + (size_t)(k0 + kk) * N + n0 + n4);
            const float gg = gk ? gk[k0 + kk] : 1.0f;
            float* tp = tile + kk * 65 + n4; tp[0] = v.x * gg; tp[1] = v.y * gg; tp[2] = v.z * gg; tp[3] = v.w * gg;
        }
        __syncthreads();
        {
            const int nn = tid >> 3, kk0 = (tid & 7) * 8;
            const float* tp = tile + kk0 * 65 + nn;
            uint4 w; w.x = pack2(tp[0], tp[65]); w.y = pack2(tp[130], tp[195]); w.z = pack2(tp[260], tp[325]); w.w = pack2(tp[390], tp[455]);
            *(uint4*)(dst + (size_t)(n0 + nn) * K + k0 + kk0) = w;
        }
        __syncthreads();
    }
}

__device__ void phase_norm(const Params& p, const float* __restrict__ src  , const float* __restrict__ g, bf16_t* __restrict__ H, float* __restrict__ Xc, float* __restrict__ Fout) {
    const int tid = tid_opaque(), lane = tid & 63, gw = blockIdx.x * 8 + (tid >> 6), nw = gridDim.x * 8;
    float4 gv[4];
#pragma unroll
    for (int k = 0; k < 4; ++k) gv[k] = *(const float4*)(g + lane * 4 + 256 * k);
    for (int r = gw; r < T_TOK; r += nw) {
        const float* row = src ? src + (size_t)r * DM : (r < 32768 ? p.x_prompt + (size_t)r * DM : p.x_sample + (size_t)(r - 32768) * DM);
        float4 v[4]; float ss = 0.f;
#pragma unroll
        for (int k = 0; k < 4; ++k) { v[k] = *(const float4*)(row + lane * 4 + 256 * k); ss += v[k].x * v[k].x + v[k].y * v[k].y + v[k].z * v[k].z + v[k].w * v[k].w; }
        ss = wave_sum(ss);
        const float rstd = 1.0f / sqrtf(ss * (1.0f / 1024.0f) + 1e-6f);
#pragma unroll
        for (int k = 0; k < 4; ++k) {
            const float a = v[k].x * rstd * gv[k].x, b = v[k].y * rstd * gv[k].y, c = v[k].z * rstd * gv[k].z, d = v[k].w * rstd * gv[k].w;
            if (H) { uint2 w; w.x = pack2(a, b); w.y = pack2(c, d); *(uint2*)(H + (size_t)r * DM + lane * 4 + 256 * k) = w; }
            if (Xc) *(float4*)(Xc + (size_t)r * DM + lane * 4 + 256 * k) = v[k];
            if (Fout) *(float4*)(Fout + (size_t)r * DM + lane * 4 + 256 * k) = make_float4(a, b, c, d);
        }
    }
}


__device__ void phase_prep_x(const Params& p, bf16_t* __restrict__ Xb, float* __restrict__ ssq) {
    const int tid = tid_opaque(), lane = tid & 63, gw = blockIdx.x * 8 + (tid >> 6), nw = gridDim.x * 8;
    for (int r = gw; r < T_TOK; r += nw) {
        const float* row = r < 32768 ? p.x_prompt + (size_t)r * DM : p.x_sample + (size_t)(r - 32768) * DM;
        float ss = 0.f;
#pragma unroll
        for (int k = 0; k < 4; ++k) { const float4 v = *(const float4*)(row + lane * 4 + 256 * k); ss += v.x * v.x + v.y * v.y + v.z * v.z + v.w * v.w;
            uint2 w; w.x = pack2(v.x, v.y); w.y = pack2(v.z, v.w); *(uint2*)(Xb + (size_t)r * DM + lane * 4 + 256 * k) = w; }
        ss = wave_sum(ss);
        if (lane < 4) ssq[(size_t)r * 4 + lane] = lane == 0 ? ss : 0.f;
    }
}

__device__ void phase_final(const bf16_t* __restrict__ Xb, const float* __restrict__ g, float* __restrict__ out) {
    const int tid = tid_opaque(), lane = tid & 63, gw = blockIdx.x * 8 + (tid >> 6), nw = gridDim.x * 8;
    for (int r = gw; r < T_TOK; r += nw) {
        float x[16]; float ss = 0.f;
#pragma unroll
        for (int k = 0; k < 2; ++k) { const uint4 w = *(const uint4*)(Xb + (size_t)r * DM + lane * 8 + 512 * k);
            x[8 * k + 0] = bflo(w.x); x[8 * k + 1] = bfhi(w.x); x[8 * k + 2] = bflo(w.y); x[8 * k + 3] = bfhi(w.y);
            x[8 * k + 4] = bflo(w.z); x[8 * k + 5] = bfhi(w.z); x[8 * k + 6] = bflo(w.w); x[8 * k + 7] = bfhi(w.w); }
#pragma unroll
        for (int k = 0; k < 16; ++k) ss += x[k] * x[k];
        ss = wave_sum(ss);
        const float rstd = 1.0f / sqrtf(ss * (1.0f / 1024.0f) + 1e-6f);
#pragma unroll
        for (int k = 0; k < 2; ++k) {
            const float4 g0 = *(const float4*)(g + lane * 8 + 512 * k), g1 = *(const float4*)(g + lane * 8 + 512 * k + 4);
            float* op = out + (size_t)r * DM + lane * 8 + 512 * k;
            *(float4*)op = make_float4(x[8 * k] * rstd * g0.x, x[8 * k + 1] * rstd * g0.y, x[8 * k + 2] * rstd * g0.z, x[8 * k + 3] * rstd * g0.w);
            *(float4*)(op + 4) = make_float4(x[8 * k + 4] * rstd * g1.x, x[8 * k + 5] * rstd * g1.y, x[8 * k + 6] * rstd * g1.z, x[8 * k + 7] * rstd * g1.w);
        }
    }
}
__device__ __forceinline__ void zero_f32(float* p, int n) { for (int i = blockIdx.x * 512 + tid_opaque(); i < n; i += gridDim.x * 512) p[i] = 0.f; }

__device__ void phase_attn_naive(const bf16_t* __restrict__ qkv, int ld, int ngroups, const float* __restrict__ rel_bias, const float* __restrict__ sink, bf16_t* __restrict__ out, int ntok) {
    const int tid = tid_opaque(), lane = tid & 63, gw = blockIdx.x * 8 + (tid >> 6), nw = gridDim.x * 8;
    for (int item = gw; item < ntok * 16; item += nw) {
        const int tok = item >> 4, h = item & 15, g = h >> 2;
        const int i = tok & (SEQ - 1), seqbase = tok - i;
        float m = sink ? sink[h] : -INFINITY, l = sink ? 1.f : 0.f, o = 0.f;
        for (int gi = 0; gi < ngroups; ++gi) {
            const int dil = ngroups == 1 ? 1 : (gi == 0 ? 1 : (gi == 1 ? 4 : 16));
            const int R = ngroups == 1 ? 128 : 64;
            const int L = SEQ / dil, t = i / dil, r = i % dil;
            const bf16_t* base = qkv + (size_t)gi * 1536;
            const float qv = bf2f(base[(size_t)tok * ld + h * 64 + lane]) * 0.125f;
            const int nb = (2 * R + 1 + 63) / 64;
            for (int b = 0; b < nb; ++b) {
                const int tp = t - R + 64 * b + lane;
                const bool valid = tp >= 0 && tp < L && tp <= t + R;
                const int tpc = min(max(tp, 0), L - 1);
                const uint4* kp = (const uint4*)(base + (size_t)(seqbase + tpc * dil + r) * ld + 1024 + g * 64);
                float s = 0.f;
#pragma unroll
                for (int c = 0; c < 8; ++c) {
                    const uint4 kv = kp[c];
                    s += rdlane(qv, c * 8 + 0) * bflo(kv.x) + rdlane(qv, c * 8 + 1) * bfhi(kv.x);
                    s += rdlane(qv, c * 8 + 2) * bflo(kv.y) + rdlane(qv, c * 8 + 3) * bfhi(kv.y);
                    s += rdlane(qv, c * 8 + 4) * bflo(kv.z) + rdlane(qv, c * 8 + 5) * bfhi(kv.z);
                    s += rdlane(qv, c * 8 + 6) * bflo(kv.w) + rdlane(qv, c * 8 + 7) * bfhi(kv.w);
                }
                s += rel_bias[rel_bucket((tp - t) * dil) * 16 + h];
                s = valid ? s : -INFINITY;
                const float bm = wave_max(s);
                if (bm == -INFINITY) continue;
                const float mn = fmaxf(m, bm);
                const float sc = __expf(m - mn);
                const float pe = valid ? __expf(s - mn) : 0.f;
                l = l * sc + wave_sum(pe);
                o *= sc;
                const int tb = t - R + 64 * b;
                for (int j = 0; j < 64; ++j) {
                    const float pj = rdlane(pe, j);
                    const int tj = min(max(tb + j, 0), L - 1);
                    o += pj * bf2f(base[(size_t)(seqbase + tj * dil + r) * ld + 1280 + g * 64 + lane]);
                }
                m = mn;
            }
        }
        out[(size_t)tok * DM + h * 64 + lane] = f2bf(o / l);
    }
}

__device__ void phase_b_stats(const bf16_t* __restrict__ Z, float2* __restrict__ stats) {
    const int tid = tid_opaque(), lane = tid & 63, gw = blockIdx.x * 8 + (tid >> 6), nw = gridDim.x * 8;
    for (int r = gw; r < CHK; r += nw) {
        const uint4* vp = (const uint4*)(Z + (size_t)r * 4096 + 2048);
        float x[32]; float s = 0.f;
#pragma unroll
        for (int k = 0; k < 4; ++k) { const uint4 w = vp[lane + 64 * k];
            x[k * 8 + 0] = bflo(w.x); x[k * 8 + 1] = bfhi(w.x); x[k * 8 + 2] = bflo(w.y); x[k * 8 + 3] = bfhi(w.y);
            x[k * 8 + 4] = bflo(w.z); x[k * 8 + 5] = bfhi(w.z); x[k * 8 + 6] = bflo(w.w); x[k * 8 + 7] = bfhi(w.w); }
#pragma unroll
        for (int k = 0; k < 32; ++k) s += x[k];
        const float mu = wave_sum(s) * (1.0f / 2048.0f);
        float q = 0.f;
#pragma unroll
        for (int k = 0; k < 32; ++k) { const float d = x[k] - mu; q += d * d; }
        const float var = wave_sum(q) * (1.0f / 2048.0f);
        if (lane == 0) stats[r] = make_float2(mu, 1.0f / sqrtf(var + 1e-5f));
    }
}

__device__ void phase_b_mix_naive(const Params& p, bf16_t* __restrict__ Z, const float2* __restrict__ stats, float* vln  ) {
    const int tid = tid_opaque();
    for (int unit = blockIdx.x; unit < 128 * 16; unit += gridDim.x) {
        const int tc = unit >> 4, cb = unit & 15, g = cb >> 1;
        for (int piece = tid; piece < 2048; piece += 512) {
            const int q = piece >> 4, c8 = (piece & 15) * 8;
            const int tok = tc * 128 + q, ch = cb * 128 + c8;
            const uint4 w = *(const uint4*)(Z + (size_t)tok * 4096 + 2048 + ch);
            const float2 st = stats[tok];
            const float4 g0 = *(const float4*)(p.b_ln_g + ch), g1 = *(const float4*)(p.b_ln_g + ch + 4), b0 = *(const float4*)(p.b_ln_b + ch), b1 = *(const float4*)(p.b_ln_b + ch + 4);
            float* d = vln + q * 128 + c8;
            d[0] = (bflo(w.x) - st.x) * st.y * g0.x + b0.x; d[1] = (bfhi(w.x) - st.x) * st.y * g0.y + b0.y;
            d[2] = (bflo(w.y) - st.x) * st.y * g0.z + b0.z; d[3] = (bfhi(w.y) - st.x) * st.y * g0.w + b0.w;
            d[4] = (bflo(w.z) - st.x) * st.y * g1.x + b1.x; d[5] = (bfhi(w.z) - st.x) * st.y * g1.y + b1.y;
            d[6] = (bflo(w.w) - st.x) * st.y * g1.z + b1.z; d[7] = (bfhi(w.w) - st.x) * st.y * g1.w + b1.w;
        }
        __syncthreads();
        const int ch = tid & 127, pq = tid >> 7;
        for (int pp = 0; pp < 32; pp += 4) {
            const int p0 = pq * 32 + pp;
            const float* w0 = p.b_ws + (size_t)(g * 128 + p0) * 128;
            float a0 = 0.f, a1 = 0.f, a2 = 0.f, a3 = 0.f;
            for (int q = 0; q < 128; ++q) {
                const float v = vln[q * 128 + ch];
                a0 += w0[q] * v; a1 += w0[128 + q] * v; a2 += w0[256 + q] * v; a3 += w0[384 + q] * v;
            }
            const float acc[4] = {a0, a1, a2, a3};
#pragma unroll
            for (int k = 0; k < 4; ++k) {
                const int pr = p0 + k;
                bf16_t* up = Z + (size_t)(tc * 128 + pr) * 4096 + cb * 128 + ch;
                *up = f2bf(bf2f(*up) * (acc[k] + p.b_bs[g * 128 + pr]));
            }
        }
        __syncthreads();
    }
}


typedef float f32x16 __attribute__((ext_vector_type(16)));
typedef short s16x4 __attribute__((ext_vector_type(4)));
__device__ __forceinline__ unsigned lds_off(const LAS void* p) { return (unsigned)(__UINTPTR_TYPE__)p; }
__device__ __forceinline__ bf16x8 tr_read2(unsigned a0, unsigned a1) {
    s16x4 r0, r1;
    asm volatile("ds_read_b64_tr_b16 %0, %2\n\tds_read_b64_tr_b16 %1, %3\n\ts_waitcnt lgkmcnt(0)" : "=&v"(r0), "=&v"(r1) : "v"(a0), "v"(a1) : "memory");
    bf16x8 r; r[0] = r0[0]; r[1] = r0[1]; r[2] = r0[2]; r[3] = r0[3]; r[4] = r1[0]; r[5] = r1[1]; r[6] = r1[2]; r[7] = r1[3]; return r;
}
constexpr int AT_KS = 144, AT_VS = 192, AT_BT = 324, AT_NKMAX = 384;
#define TR_ISSUE8(va, a0, a1, b0, b1, c0, c1, d0, d1) \
    asm volatile("ds_read_b64_tr_b16 %0, %8\n\tds_read_b64_tr_b16 %1, %8 offset:1536\n\tds_read_b64_tr_b16 %2, %8 offset:64\n\tds_read_b64_tr_b16 %3, %8 offset:1600\n\t" \
                 "ds_read_b64_tr_b16 %4, %8 offset:3072\n\tds_read_b64_tr_b16 %5, %8 offset:4608\n\tds_read_b64_tr_b16 %6, %8 offset:3136\n\tds_read_b64_tr_b16 %7, %8 offset:4672" \
                 : "=&v"(a0), "=&v"(a1), "=&v"(b0), "=&v"(b1), "=&v"(c0), "=&v"(c1), "=&v"(d0), "=&v"(d1) : "v"(va))
#define TR_WAIT8(a0, a1, b0, b1, c0, c1, d0, d1) \
    asm volatile("s_waitcnt lgkmcnt(0)" : "+v"(a0), "+v"(a1), "+v"(b0), "+v"(b1), "+v"(c0), "+v"(c1), "+v"(d0), "+v"(d1))
__device__ __forceinline__ bf16x8 cat4(s16x4 lo, s16x4 hi) { bf16x8 r; r[0] = lo[0]; r[1] = lo[1]; r[2] = lo[2]; r[3] = lo[3]; r[4] = hi[0]; r[5] = hi[1]; r[6] = hi[2]; r[7] = hi[3]; return r; }
static_assert(AT_NKMAX * (AT_KS + AT_VS) <= 131072 && 4 * AT_BT * 4 <= 16384, "attention LDS map");
static_assert(AT_VS == 192, "tr_read8 immediates: 8 rows = 1536 B, 16 rows = 3072 B, 24 rows = 4608 B");
__device__ __forceinline__ void phase_attn(const bf16_t* __restrict__ qkv, int ld, bool isC, const float* __restrict__ rel_bias, const float* __restrict__ sink,
                           bf16_t* __restrict__ out, bf16_t* __restrict__ out12, float* __restrict__ lse, LAS unsigned char* lds) {
    const int tid = tid_opaque(), lane = tid & 63, wid = __builtin_amdgcn_readfirstlane(tid >> 6), n = lane & 31, hf = lane >> 5;
    const int R = isC ? 64 : 128, NK = 128 + 2 * R, NT = R / 16 + 1;
    LAS unsigned char* Ks = lds; LAS unsigned char* Vs = lds + AT_NKMAX * AT_KS; LAS float* bT = (LAS float*)(lds + 131072 + 16 + 4096);
    const float L2E = 1.4426950408889634f;
    const int hl = wid >> 1, sb2 = wid & 1;
    int bias_key = -1;
    const int cw = ((gridDim.x & 7) == 0) ? (int)((blockIdx.x & 7) * (gridDim.x >> 3) + (blockIdx.x >> 3)) : (int)blockIdx.x;
    const bool cmap = gridDim.x == 256;
    const int nit = cmap ? 6 : (1536 - cw + (int)gridDim.x - 1) / (int)gridDim.x;
    for (int itu = 0; itu < nit; ++itu) {
        int u = cw + itu * (int)gridDim.x;
        if (cmap) { const int x = (int)(blockIdx.x & 7), rw = (int)(blockIdx.x >> 3), gq = rw >> 3, idx = (rw & 7) + 8 * itu;
            u = isC ? ((idx >> 4) * 512 + x * 64 + gq * 16 + (idx & 15)) : ((3 * x + (idx >> 4)) * 64 + gq * 16 + (idx & 15)); }
        int gi = 0, dil = 1, seq, g, r = 0, tb;
        if (isC) { gi = u >> 9; const int rem = u & 511; seq = rem >> 6; g = (rem >> 4) & 3; const int rb = rem & 15; dil = gi == 0 ? 1 : (gi == 1 ? 4 : 16); r = rb & (dil - 1); tb = rb / dil; }
        else { seq = u >> 6; g = (u >> 4) & 3; tb = u & 15; }
        const int L = SEQ / dil, t0 = tb * 128;
        const bf16_t* base = qkv + (size_t)gi * 1536;
        const size_t seqbase = (size_t)seq * SEQ;
        __syncthreads();
        {
            u32x4 kreg[6], vreg[6];
#pragma unroll
            for (int it = 0; it < 6; ++it) {
                const int idx = tid + 512 * it, row = idx >> 3, pc = idx & 7, tp = t0 - R + row;
                kreg[it] = (u32x4){0u, 0u, 0u, 0u}; vreg[it] = kreg[it];
                if (idx < NK * 8 && tp >= 0 && tp < L) { const bf16_t* src = base + (seqbase + (size_t)tp * dil + r) * ld + 1024 + g * 64 + pc * 8; kreg[it] = *(const u32x4*)src; vreg[it] = *(const u32x4*)(src + 256); }
            }
#pragma unroll
            for (int it = 0; it < 6; ++it) {
                const int idx = tid + 512 * it, row = idx >> 3, pc = idx & 7;
                if (idx < NK * 8) { *(LAS u32x4*)(Ks + row * AT_KS + pc * 16) = kreg[it]; *(LAS u32x4*)(Vs + row * AT_VS + pc * 16) = vreg[it]; }
            }
        }
        if (bias_key != gi * 4 + g) {
            bias_key = gi * 4 + g;
            for (int idx = tid; idx < 4 * AT_BT; idx += 512) {
                const int h4 = idx / AT_BT, rel = idx - h4 * AT_BT - 32;
                float v = -INFINITY;
                if (rel >= 0 && rel <= 2 * R) v = rel_bias[rel_bucket((rel - R) * dil) * 16 + g * 4 + h4] * L2E;
                bT[idx] = v;
            }
        }
        __syncthreads();
        const int hh = g * 4 + hl;
        const unsigned vlane = lds_off(Vs) + (unsigned)((4 * hf + ((lane & 15) >> 2)) * AT_VS + (16 * ((lane >> 4) & 1) + 4 * (lane & 3)) * 2);
        for (int j = 0; j < 2; ++j) {
            const int qb = sb2 * 2 + j;
            const int tq = t0 + 32 * qb + n;
            const size_t qtok = seqbase + (size_t)tq * dil + r;
            const bf16_t* qp = base + qtok * ld + hh * 64 + 8 * hf;
            bf16x8 qf[4];
#pragma unroll
            for (int ks = 0; ks < 4; ++ks) qf[ks] = *(const bf16x8*)(qp + 16 * ks);
            f32x16 o0, o1;
#pragma unroll
            for (int i = 0; i < 16; ++i) { o0[i] = 0.f; o1[i] = 0.f; }
            float m = -INFINITY, l = 0.f;
            if (sink) { m = sink[hh] * L2E; l = hf == 0 ? 1.f : 0.f; }
            const LAS float* bp = bT + hl * AT_BT + 32 - n + 4 * hf;
            const int tbase = t0 + 32 * qb - R;
            const int kt_lo = tbase < 0 ? (-tbase) >> 5 : 0, kt_hi = min(NT - 1, (L - 32 - tbase) >> 5);
            f32x16 sn;
            {
#pragma unroll
                for (int i = 0; i < 16; ++i) sn[i] = 0.f;
                const LAS unsigned char* kr = Ks + (32 * qb + 32 * kt_lo + n) * AT_KS + 16 * hf;
#pragma unroll
                for (int ks = 0; ks < 4; ++ks) sn = __builtin_amdgcn_mfma_f32_32x32x16_bf16(*(const LAS bf16x8*)(kr + 32 * ks), qf[ks], sn, 0, 0, 0);
            }
            for (int kt = kt_lo; kt <= kt_hi; ++kt) {
                const int rowb = 32 * qb + 32 * kt;
                f32x16 s = sn;
                s16x4 ta0, ta1, tb0, tb1, tc0, tc1, td0, td1;
                { const unsigned va = vlane + (unsigned)(rowb * AT_VS); TR_ISSUE8(va, ta0, ta1, tb0, tb1, tc0, tc1, td0, td1); }
                {
                    const int ktn = min(kt + 1, kt_hi);
#pragma unroll
                    for (int i = 0; i < 16; ++i) sn[i] = 0.f;
                    const LAS unsigned char* kr = Ks + (32 * qb + 32 * ktn + n) * AT_KS + 16 * hf;
#pragma unroll
                    for (int ks = 0; ks < 4; ++ks) sn = __builtin_amdgcn_mfma_f32_32x32x16_bf16(*(const LAS bf16x8*)(kr + 32 * ks), qf[ks], sn, 0, 0, 0);
                }
                float mx = -INFINITY;
                {
                    const f32x2 c2 = (f32x2){0.125f * L2E, 0.125f * L2E};
#pragma unroll
                    for (int k = 0; k < 8; ++k) { const int i = 2 * k; const LAS float* bq = bp + 32 * kt + (i & 3) + 8 * (i >> 2);
                        f32x2 v = (f32x2){s[i], s[i + 1]} * c2 + (f32x2){bq[0], bq[1]}; s[i] = v.x; s[i + 1] = v.y; }
#pragma unroll
                    for (int i = 0; i < 16; ++i) mx = fmaxf(mx, s[i]);
                }
                {
                    const u32x2 sw = __builtin_amdgcn_permlane32_swap(__float_as_uint(mx), __float_as_uint(mx), false, false);
                    mx = fmaxf(__uint_as_float(sw[0]), __uint_as_float(sw[1])); }
                const float mn = fmaxf(m, mx);
                if (__any(mn > m + 8.0f)) {
                    const float sc = __builtin_amdgcn_exp2f(m - mn);
                    l *= sc;
#pragma unroll
                    for (int i = 0; i < 16; ++i) { o0[i] *= sc; o1[i] *= sc; }
                    m = mn;
                }
                {
                    const f32x2 m2 = (f32x2){m, m}; f32x2 ps2 = (f32x2){0.f, 0.f};
#pragma unroll
                    for (int k = 0; k < 8; ++k) { const int i = 2 * k; f32x2 v = (f32x2){s[i], s[i + 1]} - m2; v.x = __builtin_amdgcn_exp2f(v.x); v.y = __builtin_amdgcn_exp2f(v.y); ps2 += v; s[i] = v.x; s[i + 1] = v.y; }
                    l += ps2.x + ps2.y;
                }
                union { bf16x8 v; unsigned w[4]; } pf0, pf1;
#pragma unroll
                for (int jj = 0; jj < 4; ++jj) { pf0.w[jj] = pg8::cvt_pk_bf16(s[2 * jj], s[2 * jj + 1]); pf1.w[jj] = pg8::cvt_pk_bf16(s[8 + 2 * jj], s[8 + 2 * jj + 1]); }
                TR_WAIT8(ta0, ta1, tb0, tb1, tc0, tc1, td0, td1);
                o0 = __builtin_amdgcn_mfma_f32_32x32x16_bf16(cat4(ta0, ta1), pf0.v, o0, 0, 0, 0);
                o1 = __builtin_amdgcn_mfma_f32_32x32x16_bf16(cat4(tb0, tb1), pf0.v, o1, 0, 0, 0);
                o0 = __builtin_amdgcn_mfma_f32_32x32x16_bf16(cat4(tc0, tc1), pf1.v, o0, 0, 0, 0);
                o1 = __builtin_amdgcn_mfma_f32_32x32x16_bf16(cat4(td0, td1), pf1.v, o1, 0, 0, 0);
            }
            l += __shfl_xor(l, 32, 64);
            const float inv = 1.0f / l;
            bf16_t* op = (gi == 0 ? out : out12 + (size_t)(gi - 1) * CHK * 1024) + qtok * 1024 + hh * 64 + 4 * hf;
#pragma unroll
            for (int gq = 0; gq < 4; ++gq) {
                uint2 w0, w1;
                w0.x = pg8::cvt_pk_bf16(o0[4 * gq] * inv, o0[4 * gq + 1] * inv); w0.y = pg8::cvt_pk_bf16(o0[4 * gq + 2] * inv, o0[4 * gq + 3] * inv);
                w1.x = pg8::cvt_pk_bf16(o1[4 * gq] * inv, o1[4 * gq + 1] * inv); w1.y = pg8::cvt_pk_bf16(o1[4 * gq + 2] * inv, o1[4 * gq + 3] * inv);
                *(uint2*)(op + 8 * gq) = w0; *(uint2*)(op + 32 + 8 * gq) = w1;
            }
            if (isC && hf == 0) lse[((size_t)gi * CHK + qtok) * 16 + hh] = (m + __log2f(l)) * 0.6931471805599453f;
        }
    }
}

__device__ void phase_c_merge(const bf16_t* __restrict__ OG, const float* __restrict__ LSE, bf16_t* Hc) {
    const int tid = tid_opaque();
    const bool cmap = gridDim.x == 256;
    const int i0 = cmap ? (int)(blockIdx.x & 7) * 262144 + (int)(blockIdx.x >> 3) * 512 + tid : (int)blockIdx.x * 512 + tid;
    const int iend = cmap ? (int)(blockIdx.x & 7) * 262144 + 262144 : CHK * 128, istep = cmap ? 16384 : (int)gridDim.x * 512;
    for (int idx = i0; idx < iend; idx += istep) {
        const int tok = idx >> 7, c8 = (idx & 127) * 8, h = c8 >> 6;
        const float l0 = LSE[(size_t)tok * 16 + h], l1 = LSE[((size_t)CHK + tok) * 16 + h], l2 = LSE[((size_t)2 * CHK + tok) * 16 + h];
        const float mx = fmaxf(l0, fmaxf(l1, l2));
        float w0 = __expf(l0 - mx), w1 = __expf(l1 - mx), w2 = __expf(l2 - mx);
        const float inv = 1.0f / (w0 + w1 + w2); w0 *= inv; w1 *= inv; w2 *= inv;
        const uint4 a = *(const uint4*)(Hc + (size_t)tok * 1024 + c8), b = *(const uint4*)(OG + (size_t)tok * 1024 + c8), c = *(const uint4*)(OG + ((size_t)CHK + tok) * 1024 + c8);
        uint4 o;
        o.x = pack2(w0 * bflo(a.x) + w1 * bflo(b.x) + w2 * bflo(c.x), w0 * bfhi(a.x) + w1 * bfhi(b.x) + w2 * bfhi(c.x));
        o.y = pack2(w0 * bflo(a.y) + w1 * bflo(b.y) + w2 * bflo(c.y), w0 * bfhi(a.y) + w1 * bfhi(b.y) + w2 * bfhi(c.y));
        o.z = pack2(w0 * bflo(a.z) + w1 * bflo(b.z) + w2 * bflo(c.z), w0 * bfhi(a.z) + w1 * bfhi(b.z) + w2 * bfhi(c.z));
        o.w = pack2(w0 * bflo(a.w) + w1 * bflo(b.w) + w2 * bflo(c.w), w0 * bfhi(a.w) + w1 * bfhi(b.w) + w2 * bfhi(c.w));
        *(uint4*)(Hc + (size_t)tok * 1024 + c8) = o;
    }
}

constexpr int BM_VS = 576, BM_WS = 272;
__device__ void phase_b_mix(const Params& p, const bf16_t* __restrict__ Z, bf16_t* __restrict__ Gt, const float2* __restrict__ stats, const bf16_t* __restrict__ WsB, LAS unsigned char* lds) {
    const int tid = tid_opaque(), lane = tid & 63, wid = __builtin_amdgcn_readfirstlane(tid >> 6), n = lane & 31, hf = lane >> 5;
    LAS unsigned char* Vl = lds; LAS unsigned char* Wl = lds + 128 * BM_VS; LAS float* stl = (LAS float*)(lds + 128 * BM_VS + 128 * BM_WS);
    const bool rmap = gridDim.x == 256;
    for (int unit = blockIdx.x; unit < 128 * 8; unit += gridDim.x) {
        int tc = unit >> 3, g = unit & 7;
        if (rmap) { const int idx = (int)(blockIdx.x >> 3) + 32 * (unit >> 8); tc = 16 * (int)(blockIdx.x & 7) + (idx >> 3); g = idx & 7; }
        __syncthreads();
        if (tid < 128) {
            const f32x4* sp = (const f32x4*)(stats + (size_t)(tc * 128 + tid) * 8);
            const f32x4 a = sp[0], b = sp[1], c = sp[2], d = sp[3];
            const float S1 = ((a[0] + a[2]) + (b[0] + b[2])) + ((c[0] + c[2]) + (d[0] + d[2])), S2 = ((a[1] + a[3]) + (b[1] + b[3])) + ((c[1] + c[3]) + (d[1] + d[3]));
            const float mu = S1 * (1.0f / 2048.0f), var = fmaxf(S2 * (1.0f / 2048.0f) - mu * mu, 0.f);
            stl[2 * tid] = mu; stl[2 * tid + 1] = 1.0f / sqrtf(var + 1e-5f);
        }
        for (int piece = tid; piece < 2048; piece += 512) {
            const int pr = piece >> 4, c8 = (piece & 15) * 8;
            *(LAS u32x4*)(Wl + pr * BM_WS + c8 * 2) = *(const u32x4*)(WsB + (size_t)(g * 128 + pr) * 128 + c8);
        }
        __syncthreads();
        {
            const int c8 = (tid & 31) * 8, ch = g * 256 + c8;
            const float4 g0 = *(const float4*)(p.b_ln_g + ch), g1 = *(const float4*)(p.b_ln_g + ch + 4), b0 = *(const float4*)(p.b_ln_b + ch), b1 = *(const float4*)(p.b_ln_b + ch + 4);
            uint4 wv[8];
#pragma unroll
            for (int it = 0; it < 8; ++it) { const int q = (tid >> 5) + 16 * it; wv[it] = *(const uint4*)(Z + (size_t)(tc * 128 + q) * 4096 + 2048 + ch); }
#pragma unroll
            for (int it = 0; it < 8; ++it) {
                const int q = (tid >> 5) + 16 * it; const uint4 w = wv[it];
                const float2 st = make_float2(stl[2 * q], stl[2 * q + 1]);
                u32x4 o;
                o.x = pack2((bflo(w.x) - st.x) * st.y * g0.x + b0.x, (bfhi(w.x) - st.x) * st.y * g0.y + b0.y);
                o.y = pack2((bflo(w.y) - st.x) * st.y * g0.z + b0.z, (bfhi(w.y) - st.x) * st.y * g0.w + b0.w);
                o.z = pack2((bflo(w.z) - st.x) * st.y * g1.x + b1.x, (bfhi(w.z) - st.x) * st.y * g1.y + b1.y);
                o.w = pack2((bflo(w.w) - st.x) * st.y * g1.z + b1.z, (bfhi(w.w) - st.x) * st.y * g1.w + b1.w);
                *(LAS u32x4*)(Vl + q * BM_VS + c8 * 2) = o;
            }
        }
        __syncthreads();
        f32x16 acc[4];
#pragma unroll
        for (int pt = 0; pt < 4; ++pt)
#pragma unroll
            for (int i = 0; i < 16; ++i) acc[pt][i] = 0.f;
        const unsigned va = lds_off(Vl) + (unsigned)((8 * hf + ((lane & 15) >> 2)) * BM_VS + (32 * wid + 16 * ((lane >> 4) & 1) + 4 * (lane & 3)) * 2);
        const LAS unsigned char* wb = Wl + n * BM_WS + 16 * hf;
#pragma unroll 2
        for (int ks = 0; ks < 8; ++ks) {
            const bf16x8 af = tr_read2(va + (unsigned)(16 * ks * BM_VS), va + (unsigned)((16 * ks + 4) * BM_VS));
#pragma unroll
            for (int pt = 0; pt < 4; ++pt) { const bf16x8 bf = *(const LAS bf16x8*)(wb + pt * 32 * BM_WS + 32 * ks); acc[pt] = __builtin_amdgcn_mfma_f32_32x32x16_bf16(af, bf, acc[pt], 0, 0, 0); }
        }
#pragma unroll
        for (int pt = 0; pt < 4; ++pt) {
            const int pr = 32 * pt + n;
            const float bs = p.b_bs[g * 128 + pr];
            const bf16_t* up = Z + (size_t)(tc * 128 + pr) * 4096 + g * 256 + 32 * wid + 4 * hf;
            bf16_t* gp = Gt + (size_t)(tc * 128 + pr) * 2048 + g * 256 + 32 * wid + 4 * hf;
#pragma unroll
            for (int gq = 0; gq < 4; ++gq) {
                const uint2 uw = *(const uint2*)(up + 8 * gq);
                uint2 o;
                o.x = pg8::cvt_pk_bf16(bflo(uw.x) * (acc[pt][4 * gq] + bs), bfhi(uw.x) * (acc[pt][4 * gq + 1] + bs));
                o.y = pg8::cvt_pk_bf16(bflo(uw.y) * (acc[pt][4 * gq + 2] + bs), bfhi(uw.y) * (acc[pt][4 * gq + 3] + bs));
                *(uint2*)(gp + 8 * gq) = o;
            }
        }
    }
}

struct Prog { unsigned v[192]; int n; };
constexpr Prog make_prog() {
    Prog P{}; int n = 0;
    auto add = [&](int type, int layer, int chunk) { const int reps = 1 + (type == PROBE_TYPE ? PROBE_REP : 0); for (int q = 0; q < reps; ++q) P.v[n++] = (unsigned)type | ((unsigned)layer << 8) | ((unsigned)chunk << 16) | (q + 1 < reps ? (1u << 24) : 0u); };
    add(PH_PREP, 0, 0);
    if (PROBE_TYPE == 99) for (int q = 0; q < PROBE_REP; ++q) P.v[n++] = 99u;
    for (int i = 0; i < 4; ++i) {
        const int kind = i % 3;
        if (kind == 0) { add(PH_A_QKV, i, 0); add(PH_A_ATTN, i, 0); add(PH_A_WO, i, 0); }
        else if (kind == 1) { for (int c = 0; c < NCHK; ++c) { add(PH_B_IN, i, c); add(PH_B_MIX, i, c); add(PH_B_OUT, i, c); } }
        else { for (int c = 0; c < NCHK; ++c) { add(PH_C_QKV, i, c); add(PH_C_ATTN, i, c); add(PH_C_MERGE, i, c); } add(PH_C_WO, i, 0); }
        for (int c = 0; c < NCHK; ++c) { add(PH_FFN1, i, c); add(PH_FFN2, i, c); }
    }
    add(PH_FINAL, 0, 0);
    P.n = n; return P;
}
constexpr Prog h_prog = make_prog();
__device__ const Prog d_prog = make_prog();

__global__ void __launch_bounds__(512, 2) mega(Params p, int pb, int pe) {
    extern __shared__ __attribute__((aligned(16))) unsigned char shm[];
    cg::grid_group grid = cg::this_grid();
    bf16_t* const Wt = (bf16_t*)(p.ws + WS_WT);
    bf16_t* const H = (bf16_t*)(p.ws + WS_H);
    bf16_t* const Pb = (bf16_t*)(p.ws + WS_P);
    float* const ssq0 = (float*)(p.ws + WS_S + S_SSQ0);
    float* const ssq1 = (float*)(p.ws + WS_S + S_SSQ1);
    unsigned char* const S = p.ws + WS_S;
    volatile LAS unsigned* st = (volatile LAS unsigned*)((LAS unsigned char*)shm + 131072);
    unsigned* const bar = (unsigned*)(p.ws + WS_BAR);
    if (pe - pb > 1) {
        if (blockIdx.x == 0) for (int i = threadIdx.x; i < XCD_BAR_WORDS; i += 512) bar[i] = 0u;
        if (threadIdx.x < 4) st[threadIdx.x] = 0u;
    }
    XcdBarrier xb; xb.bar = bar; xb.x = 0u; xb.st = st;
    for (int ph = pb; ph < pe; ++ph) {
        if (ph == pb + 1) { grid.sync(); xb = xcd_barrier_post(bar, st); }
        else if (ph > pb + 1) { const unsigned cd = d_prog.v[ph]; const int ty = cd & 0xff, ck = (cd >> 16) & 0xff, ly = (cd >> 8) & 0xff;
            if (__builtin_amdgcn_readfirstlane((int)st[3]) == 1 && (ty == PH_FFN2 || (ty == PH_FFN1 && (ck > 0 || ly == 1 || ly == 2)) || ty == PH_B_MIX || ty == PH_B_OUT || ty == PH_B_IN ||
                 ty == PH_A_ATTN || ty == PH_A_WO || ty == PH_C_ATTN || ty == PH_C_MERGE || (ty == PH_C_QKV && ck > 0))) xcd_local_barrier(xb); else xcd_barrier(xb); }
        const unsigned code = d_prog.v[ph];
        const int type = code & 0xff, layer = (code >> 8) & 0xff, chunk = (code >> 16) & 0xff;
        pg8::Gemm g; g.A = nullptr; g.Bt = nullptr; g.M = 0; g.N = 0; g.K = 0; g.lda = 0;
        void* outp = nullptr; int ldc = 0, epi = -1;
        const size_t crow = (size_t)chunk * CHK;
        const float* rssq = nullptr; float* wssq = nullptr; float* zssq = nullptr;
        switch (type) {
            case PH_A_QKV: g.A = Pb; g.lda = 1024; g.Bt = Wt + OFF_AQKV + (size_t)(layer / 3) * 1572864; g.M = T_TOK; g.N = 1536; g.K = 1024; outp = S; ldc = 1536; epi = 0; rssq = ssq0; break;
            case PH_A_WO:  g.A = H; g.lda = 1024; g.Bt = Wt + OFF_AWO + (size_t)(layer / 3) * 1048576; g.M = T_TOK; g.N = 1024; g.K = 1024; epi = 3; wssq = ssq1; break;
            case PH_FFN1:  g.A = Pb + crow * 1024; g.lda = 1024; g.Bt = Wt + OFF_W1 + (size_t)layer * 4194304; g.M = CHK; g.N = 4096; g.K = 1024; outp = S; ldc = 4096; epi = 2; rssq = ssq1 + crow * 4; break;
            case PH_FFN2:  g.A = (const bf16_t*)S; g.lda = 4096; g.Bt = Wt + OFF_W2 + (size_t)layer * 4194304; g.M = CHK; g.N = 1024; g.K = 4096; epi = 3; wssq = ssq0; break;
            case PH_B_IN:  g.A = Pb + crow * 1024; g.lda = 1024; g.Bt = Wt + OFF_BWIN; g.M = CHK; g.N = 4096; g.K = 1024; outp = S; ldc = 4096; epi = 1; rssq = ssq0 + crow * 4; break;
            case PH_B_OUT: g.A = (const bf16_t*)(S + S_GATE); g.lda = 2048; g.Bt = Wt + OFF_BWO; g.M = CHK; g.N = 1024; g.K = 2048; epi = 3; wssq = ssq1; break;
            case PH_C_QKV: g.A = Pb + crow * 1024; g.lda = 1024; g.Bt = Wt + OFF_CQKV; g.M = CHK; g.N = 4608; g.K = 1024; outp = S; ldc = 4608; epi = 0; rssq = ssq0 + crow * 4; break;
            case PH_C_WO:  g.A = H; g.lda = 1024; g.Bt = Wt + OFF_CWO; g.M = T_TOK; g.N = 1024; g.K = 1024; epi = 3; wssq = ssq1; break;
            default: break;
        }
        if (epi >= 0) {
            if (zssq) zero_f32(zssq, T_TOK);
            const size_t xrow = (g.M == CHK) ? crow : 0;
            pg8::StaticOrder so; so.init(g.M, g.N, (int)gridDim.x, (int)blockIdx.x, type == PH_C_WO);
            if (epi == 0) { pg8::EpiBf16<0> E; E.O = (bf16_t*)outp; E.ldc = ldc; E.ssq = rssq; E.stat = nullptr; E.red2 = nullptr; E.rsl = (LAS float*)((LAS unsigned char*)shm + 131072 + 16 + 4096); pg8::gemm_phase((LAS unsigned char*)shm, g, so, E); }
            else if (epi == 1) { pg8::EpiBf16<1> E; E.O = (bf16_t*)outp; E.ldc = ldc; E.ssq = rssq; E.rsl = (LAS float*)((LAS unsigned char*)shm + 131072 + 16 + 4096); E.stat = (float2*)(S + S_STATS); E.red2 = (LAS float*)((LAS unsigned char*)shm + 131072 + 16 + 4096 + 16384); pg8::gemm_phase((LAS unsigned char*)shm, g, so, E); }
            else if (epi == 2) { pg8::EpiBf16<2> E; E.O = (bf16_t*)outp; E.ldc = ldc; E.ssq = rssq; E.stat = nullptr; E.red2 = nullptr; E.rsl = (LAS float*)((LAS unsigned char*)shm + 131072 + 16 + 4096); pg8::gemm_phase((LAS unsigned char*)shm, g, so, E); }
            else { pg8::EpiRes E; E.Cb = Pb + xrow * 1024; E.ssq = wssq + xrow * 4; E.red = (LAS float*)((LAS unsigned char*)shm + 131072 + 16); pg8::gemm_phase((LAS unsigned char*)shm, g, so, E); }
            continue;
        }
        switch (type) {
            case PH_PREP: {
                float* tile = (float*)shm;
                for (int i = 0; i < 4; ++i) convert_T(p.ffn_w1 + (size_t)i * 4194304, Wt + OFF_W1 + (size_t)i * 4194304, 1024, 4096, tile, p.norm_ffn_g + i * DM);
                for (int i = 0; i < 4; ++i) convert_T(p.ffn_w2 + (size_t)i * 4194304, Wt + OFF_W2 + (size_t)i * 4194304, 4096, 1024, tile);
                for (int j = 0; j < 2; ++j) convert_T(p.a_wqkv + (size_t)j * 1572864, Wt + OFF_AQKV + (size_t)j * 1572864, 1024, 1536, tile, p.norm_mix_g + (3 * j) * DM);
                for (int j = 0; j < 2; ++j) convert_T(p.a_wo + (size_t)j * 1048576, Wt + OFF_AWO + (size_t)j * 1048576, 1024, 1024, tile);
                convert_T(p.b_win, Wt + OFF_BWIN, 1024, 4096, tile, p.norm_mix_g + 1 * DM);
                convert_T(p.b_wo, Wt + OFF_BWO, 2048, 1024, tile);
                convert_T(p.c_wqkv, Wt + OFF_CQKV, 1024, 4608, tile, p.norm_mix_g + 2 * DM);
                convert_T(p.c_wo, Wt + OFF_CWO, 1024, 1024, tile);
                for (int i = blockIdx.x * 512 + tid_opaque(); i < 131072; i += gridDim.x * 512) Wt[OFF_BWS + i] = f2bf(p.b_ws[i]);
                phase_prep_x(p, Pb, ssq0);
            } break;
            case PH_FINAL:    phase_final(Pb, p.final_g, p.X); break;
#if NAIVE_ATTN
            case PH_A_ATTN:   phase_attn_naive((const bf16_t*)S, 1536, 1, p.rel_bias, p.a_sink + (layer / 3) * 16, H, T_TOK); break;
            case PH_C_ATTN:   phase_attn_naive((const bf16_t*)S, 4608, 3, p.rel_bias, nullptr, H + crow * 1024, CHK); break;
#else
            case PH_A_ATTN: case PH_C_ATTN: {
                const bool isC = type == PH_C_ATTN;
                phase_attn((const bf16_t*)S, isC ? 4608 : 1536, isC, p.rel_bias, isC ? nullptr : p.a_sink + (layer / 3) * 16, isC ? H + crow * 1024 : H,
                           isC ? (bf16_t*)(S + S_OG) : nullptr, isC ? (float*)(S + S_LSE) : nullptr, (LAS unsigned char*)shm);
            } break;
            case PH_C_MERGE:  phase_c_merge((const bf16_t*)(S + S_OG), (const float*)(S + S_LSE), H + crow * 1024); break;
#endif
            case PH_B_STATS:  phase_b_stats((const bf16_t*)S, (float2*)(S + S_STATS)); break;
#if NAIVE_MIX
            case PH_B_MIX:    phase_b_mix_naive(p, (bf16_t*)S, (const float2*)(S + S_STATS), (float*)shm); break;
#else
            case PH_B_MIX:    phase_b_mix(p, (const bf16_t*)S, (bf16_t*)(S + S_GATE), (const float2*)(S + S_STATS), Wt + OFF_BWS, (LAS unsigned char*)shm); break;
#endif
            default: break;
        }
    }
}

extern "C" void kernel_launch(void* const* d_in, const int* in_sizes, int n_in, void* d_out, int out_size, void* d_ws, size_t ws_size, hipStream_t stream) {
    if (n_in != 19 || out_size != T_TOK * DM || ws_size < WS_NEED) { fprintf(stderr, "kernel_launch: unexpected sizes n_in %d out %d ws %zu\n", n_in, out_size, ws_size); return; }
    Params p; memset(&p, 0, sizeof(p));
    const float** f = (const float**)&p;
    for (int i = 0; i < 19; ++i) f[i] = (const float*)d_in[i];
    p.X = (float*)d_out; p.ws = (unsigned char*)d_ws;
    static int grid = 0;
    if (!grid) {
        int dev = 0, cus = 0, per_cu = 0;
        hipGetDevice(&dev); hipDeviceGetAttribute(&cus, hipDeviceAttributeMultiprocessorCount, dev);
        hipFuncSetAttribute((const void*)mega, hipFuncAttributeMaxDynamicSharedMemorySize, LDS_BYTES);
        hipOccupancyMaxActiveBlocksPerMultiprocessor(&per_cu, (const void*)mega, 512, LDS_BYTES);
        if (per_cu < 1) { fprintf(stderr, "kernel_launch: occupancy query says %d blocks per CU\n", per_cu); per_cu = 1; }
        grid = cus * per_cu;
        (void)hipGetLastError();
    }
#if ONE_LAUNCH
    int pb = 0, pe = h_prog.n;
    void* args[] = {&p, &pb, &pe};
    hipError_t e = hipLaunchCooperativeKernel((const void*)mega, dim3(grid), dim3(512), args, LDS_BYTES, stream);
    if (e != hipSuccess) fprintf(stderr, "cooperative launch failed: %s (grid %d)\n", hipGetErrorString(e), grid);
#else
    for (int ph = 0; ph < h_prog.n; ++ph) hipLaunchKernelGGL(mega, dim3(grid), dim3(512), LDS_BYTES, stream, p, ph, ph + 1);
#endif
}
```

```cpp
#include <hip/hip_runtime.h>
#include <hip/hip_cooperative_groups.h>
#include <cstdio>
#include <cstring>
namespace cg = cooperative_groups;

#ifndef NAIVE_ATTN
#define NAIVE_ATTN 0
#endif
#ifndef NAIVE_MIX
#define NAIVE_MIX 0
#endif
#ifndef PROBE_TYPE
#define PROBE_TYPE 0
#endif
#ifndef PROBE_REP
#define PROBE_REP 0
#endif
#ifndef ONE_LAUNCH
#define ONE_LAUNCH 1
#endif

#define LAS __attribute__((address_space(3)))
typedef unsigned short bf16_t;
typedef short bf16x8 __attribute__((ext_vector_type(8)));
typedef float f32x4 __attribute__((ext_vector_type(4)));
typedef float f32x2 __attribute__((ext_vector_type(2)));
typedef unsigned u32x4 __attribute__((ext_vector_type(4)));
typedef unsigned u32x2 __attribute__((ext_vector_type(2)));

constexpr int T_TOK = 49152, DM = 1024, SEQ = 2048, CHK = 16384, NCHK = 3;
constexpr int LDS_BYTES = 131072 + 16 + 4096 + 16384 + 8192;
constexpr size_t OFF_W1 = 0, OFF_W2 = 16777216, OFF_AQKV = 33554432, OFF_AWO = 36700160, OFF_BWIN = 38797312, OFF_BWO = 42991616,
                 OFF_CQKV = 45088768, OFF_CWO = 49807360, OFF_BWS = 50855936, WT_END = 50987008;
constexpr size_t WS_WT = 0, WS_P = 104857600, WS_H = WS_P + (size_t)T_TOK * DM * 2, WS_S = WS_H + (size_t)T_TOK * DM * 2, WS_NEED = 536870912;
constexpr size_t WS_SSQ0 = 0, WS_SSQ1 = 0;
constexpr size_t S_OG = 150994944, S_LSE = S_OG + 2 * (size_t)CHK * 1024 * 2;
constexpr size_t WS_BAR = 102236160;
constexpr size_t S_SSQ0 = 224395264, S_SSQ1 = S_SSQ0 + (size_t)T_TOK * 64;
static_assert(WS_S + S_SSQ1 + (size_t)T_TOK * 64 <= WS_NEED && S_SSQ0 >= S_LSE + 3 * (size_t)CHK * 64, "ssq buffers");
constexpr size_t S_STATS = 134217728;
constexpr size_t S_GATE = 142606336;

enum { PH_PREP = 1, PH_A_QKV, PH_A_ATTN, PH_A_WO, PH_NORM_FFN, PH_FFN1, PH_FFN2, PH_NORM_MIX, PH_B_IN, PH_B_STATS, PH_B_MIX, PH_B_OUT, PH_C_QKV, PH_C_ATTN, PH_C_WO, PH_FINAL, PH_C_MERGE };
static_assert(WS_S + S_LSE + 3 * (size_t)CHK * 16 * 4 <= WS_NEED, "workspace");

struct Params {
    const float* x_prompt; const float* x_sample; const float* rel_bias; const float* norm_mix_g; const float* norm_ffn_g; const float* final_g;
    const float* ffn_w1; const float* ffn_w2; const float* a_wqkv; const float* a_sink; const float* a_wo;
    const float* b_win; const float* b_ln_g; const float* b_ln_b; const float* b_ws; const float* b_bs; const float* b_wo;
    const float* c_wqkv; const float* c_wo;
    float* X; unsigned char* ws;
};

__device__ __forceinline__ bf16_t f2bf(float f) { unsigned u = __float_as_uint(f); u += 0x7FFFu + ((u >> 16) & 1u); return (bf16_t)(u >> 16); }
__device__ __forceinline__ float bf2f(bf16_t b) { return __uint_as_float(((unsigned)b) << 16); }
__device__ __forceinline__ float bflo(unsigned w) { return __uint_as_float(w << 16); }
__device__ __forceinline__ float bfhi(unsigned w) { return __uint_as_float(w & 0xffff0000u); }
__device__ __forceinline__ unsigned pack2(float lo, float hi) { return (unsigned)f2bf(lo) | ((unsigned)f2bf(hi) << 16); }
__device__ __forceinline__ float wave_sum(float v) { for (int o = 32; o > 0; o >>= 1) v += __shfl_xor(v, o, 64); return v; }
__device__ __forceinline__ float wave_max(float v) { for (int o = 32; o > 0; o >>= 1) v = fmaxf(v, __shfl_xor(v, o, 64)); return v; }
__device__ __forceinline__ int tid_opaque() { int t = threadIdx.x; asm volatile("" : "+v"(t)); return t; }
__device__ __forceinline__ float rdlane(float v, int l) { return __int_as_float(__builtin_amdgcn_readlane(__float_as_int(v), l)); }


#define XB_TMO      128
#define XB_XCNT(j)  (256  + 64 * (j))
#define XB_XSUB(j)  (1280 + 64 * (j))
#define XB_XGEN(j)  (2304 + 64 * (j))
#define XB_TOP      3328
#define XB_TOPGEN   3392
#define XB_LSUB(j)  (3456 + 64 * (j))
#define XB_LGEN(j)  (4480 + 64 * (j))
#define XCD_BAR_WORDS 5504
#define XB_SPIN_CAP (1u << 22)
__device__ __forceinline__ unsigned xb_ld(unsigned* p)              { return __hip_atomic_load(p, __ATOMIC_RELAXED, __HIP_MEMORY_SCOPE_AGENT); }
__device__ __forceinline__ unsigned xb_add(unsigned* p, unsigned v) { return __hip_atomic_fetch_add(p, v, __ATOMIC_RELAXED, __HIP_MEMORY_SCOPE_AGENT); }
__device__ __forceinline__ unsigned xb_xcc_id() { return (unsigned)__builtin_amdgcn_s_getreg((3 << 11) | 20) & 0xFu; }
#define XB_SPIN(cond, bar) do { unsigned _sp = 0; while (cond) { __builtin_amdgcn_s_sleep(1); \
    if ((++_sp & 255u) == 0u) { if (xb_ld(&(bar)[XB_TMO])) break; if (_sp > XB_SPIN_CAP) { atomicAdd(&(bar)[XB_TMO], 1u); break; } } } } while (0)
struct XcdBarrier { unsigned* bar; unsigned x; volatile LAS unsigned* st; };
__device__ __forceinline__ XcdBarrier xcd_barrier_post(unsigned* bar, volatile LAS unsigned* st) {
    XcdBarrier b; b.bar = bar; b.x = xb_xcc_id(); b.st = st;
    if (threadIdx.x == 0) { const unsigned rho = blockIdx.x & 7u; (void)xb_add(&bar[XB_XCNT(b.x)], 1u | (rho << 9) | ((rho * rho) << 20)); }
    return b;
}
__device__ __forceinline__ void xcd_barrier_complete(unsigned* bar, unsigned x, unsigned& nloc, unsigned& nx, bool& rr) {
    const unsigned G = gridDim.x * gridDim.y * gridDim.z;
    unsigned sum, cnt, mine, mism, even, sp = 0u;
    for (;;) {
        sum = 0u; cnt = 0u; mine = 0u; mism = 0u; even = 1u;
#pragma unroll
        for (unsigned j = 0; j < 16; ++j) { const unsigned w = xb_ld(&bar[XB_XCNT(j)]); const unsigned c = w & 0x1ffu, sr = (w >> 9) & 0x7ffu, sq = w >> 20; sum += c; cnt += (c > 0u) ? 1u : 0u; mine = (j == x) ? c : mine;
            mism += (c * sq != sr * sr) ? 1u : 0u;
            even &= (j < 8u ? c == (G >> 3) : w == 0u) ? 1u : 0u; }
        if (sum == G) break;
        __builtin_amdgcn_s_sleep(1);
        if ((++sp & 255u) == 0u) { if (xb_ld(&bar[XB_TMO])) break; if (sp > XB_SPIN_CAP) { atomicAdd(&bar[XB_TMO], 1u); break; } }
    }
    nloc = mine > 0u ? mine : 1u; nx = cnt > 0u ? cnt : 1u;
    rr = (sum == G) && (mism == 0u) && (even != 0u) && (G == 256u);
}
__device__ __forceinline__ void xcd_barrier(const XcdBarrier& b) {
    asm volatile("s_waitcnt vmcnt(0)" ::: "memory");
    __syncthreads();
    if (threadIdx.x == 0) {
        unsigned* bar = b.bar;
        __builtin_amdgcn_s_waitcnt(0);
        unsigned nloc = b.st[0], nx = b.st[1];
        if (nloc == 0u) { bool rr = false; xcd_barrier_complete(bar, b.x, nloc, nx, rr); b.st[0] = nloc; b.st[1] = nx; b.st[3] = rr ? 1u : 0u; }
        const unsigned old = xb_add(&bar[XB_XSUB(b.x)], 1u);
        const unsigned gen = old / nloc;
        if (old + 1u == (gen + 1u) * nloc) {
            __builtin_amdgcn_fence(__ATOMIC_RELEASE, "agent");
            asm volatile("s_waitcnt vmcnt(0)" ::: "memory");
            const unsigned og = xb_add(&bar[XB_TOP], 1u);
            const unsigned tg = og / nx;
            if (og + 1u == (tg + 1u) * nx) xb_add(&bar[XB_TOPGEN], 1u);
            else XB_SPIN(xb_ld(&bar[XB_TOPGEN]) == tg, bar);
            __builtin_amdgcn_fence(__ATOMIC_ACQUIRE, "agent");
            xb_add(&bar[XB_XGEN(b.x)], 1u);
            asm volatile("s_waitcnt vmcnt(0)" ::: "memory");
        } else {
            XB_SPIN(xb_ld(&bar[XB_XGEN(b.x)]) == gen, bar);
            __builtin_amdgcn_fence(__ATOMIC_ACQUIRE, "agent");
            asm volatile("s_waitcnt vmcnt(0)" ::: "memory");
        }
    }
    __syncthreads();
}

__device__ __forceinline__ void xcd_local_barrier(const XcdBarrier& b) {
    asm volatile("s_waitcnt vmcnt(0)" ::: "memory");
    __syncthreads();
    if (threadIdx.x == 0) {
        unsigned* bar = b.bar;
        __builtin_amdgcn_s_waitcnt(0);
        const unsigned nloc = b.st[0];
        const unsigned old = xb_add(&bar[XB_LSUB(b.x)], 1u);
        const unsigned gen = old / nloc;
        if (old + 1u == (gen + 1u) * nloc) xb_add(&bar[XB_LGEN(b.x)], 1u);
        else XB_SPIN(xb_ld(&bar[XB_LGEN(b.x)]) == gen, bar);
        __builtin_amdgcn_fence(__ATOMIC_ACQUIRE, "agent");
        asm volatile("s_waitcnt vmcnt(0)" ::: "memory");
    }
    __syncthreads();
}

namespace pg8 {
constexpr int BM = 256, BK = 64, HALF = 128, HTB = HALF * BK * 2, STAGE_BYTES = 8 * HTB, NXCD = 8, WGM = 4;
__host__ __device__ __forceinline__ int lds_byte(int r, int c) { const int st = (r >> 4) * 2 + (c >> 5), rr = r & 15, cc = c & 31, ob = rr * 64 + cc * 2; return st * 1024 + (ob ^ (((ob >> 9) & 1) << 5)); }
__host__ __device__ __forceinline__ void stage_rc(int b, int& R, int& C) { const int st = b / 1024, sb = b % 1024, swz = sb ^ (((sb >> 9) & 1) << 5); R = (st >> 1) * 16 + swz / 64; C = (st & 1) * 32 + (swz % 64) / 2; }
__host__ __device__ __forceinline__ int perm32(int rho) { const int n = rho >> 4, i = rho & 15; return 8 * (i >> 2) + 4 * n + (i & 3); }
struct Unit { int pm, pn; };
struct Gemm { const bf16_t* A; const bf16_t* Bt; int M, N, K, lda; };
struct StaticOrder {
    int nM, nN, nwg, G, c; bool permT;
    __device__ void init(int M, int N, int G_, int c_, bool permT_ = false) { nM = M / BM; nN = N / BM; nwg = nM * nN; G = G_; c = c_; permT = permT_ && nM == 192 && nN == 4 && G_ == 256; }
    __device__ bool next(int i, Unit& u) const {
        const long L = (long)i * G + c; if (L >= nwg) return false;
        int wgid = (int)L; { const int q = nwg / NXCD, r = nwg % NXCD, xcd = wgid % NXCD, off = wgid / NXCD; wgid = (xcd < r ? xcd * (q + 1) : r * (q + 1) + (xcd - r) * q) + off; }
        const int nig = WGM * nN, gid = wgid / nig, fm = gid * WGM, gsz = (nM - fm) < WGM ? (nM - fm) : WGM;
        u.pm = fm + ((wgid % nig) % gsz); u.pn = (wgid % nig) / gsz;
        if (permT) { const int x = u.pm / 24, j = u.pm - 24 * x; u.pm = 64 * (j >> 3) + 8 * x + (j & 7); }
        return true;
    }
};
__device__ __forceinline__ unsigned cvt_pk_bf16(float lo, float hi) { unsigned r; asm volatile("v_cvt_pk_bf16_f32 %0, %1, %2" : "=v"(r) : "v"(lo), "v"(hi)); return r; }
__device__ __forceinline__ f32x2 gelu_pk(f32x2 v) {
    const f32x2 av = __builtin_elementwise_abs(v), d = av * 0.2316418882f + 1.0f;
    f32x2 t; t.x = __builtin_amdgcn_rcpf(d.x); t.y = __builtin_amdgcn_rcpf(d.y);
    f32x2 q = t * 0.5307027145f + (-0.7265760135f); q = q * t + 0.7107068705f; q = q * t + (-0.142248368f); q = q * t + 0.127414796f; q = q * t;
    const f32x2 s = (v * v) * (-0.72134752044f);
    f32x2 e; e.x = __builtin_amdgcn_exp2f(s.x); e.y = __builtin_amdgcn_exp2f(s.y);
    const f32x2 m = v * (q * e), r = v - m;
    f32x2 o; o.x = v.x < 0.f ? m.x : r.x; o.y = v.y < 0.f ? m.y : r.y; return o;
}
struct EpiRes {
    static constexpr bool PERM = true;
    bf16_t* Cb; float* ssq; LAS float* red;
    __device__ __forceinline__ void init(f32x4 (&acc)[2][2][4][2], const Unit& u, int wr, int wc, int fr, int fq) const {
        const int row0 = u.pm * BM + wr * 64 + fr, col0 = u.pn * BM + wc * 32 + 8 * fq;
#pragma unroll
        for (int ai = 0; ai < 2; ++ai)
#pragma unroll
            for (int m = 0; m < 4; ++m) { const bf16_t* rowp = Cb + (size_t)(row0 + ai * HALF + m * 16) * DM + col0;
#pragma unroll
                for (int bj = 0; bj < 2; ++bj) { const u32x4 w = *(const u32x4*)(rowp + bj * HALF);
                    acc[ai][bj][m][0] = (f32x4){bflo(w.x), bfhi(w.x), bflo(w.y), bfhi(w.y)}; acc[ai][bj][m][1] = (f32x4){bflo(w.z), bfhi(w.z), bflo(w.w), bfhi(w.w)}; } }
    }
    __device__ __forceinline__ void operator()(const f32x4 (&acc)[2][2][4][2], const Unit& u, int wr, int wc, int fr, int fq) const {
        const int row0 = u.pm * BM + wr * 64 + fr, col0 = u.pn * BM + wc * 32 + 8 * fq;
#pragma unroll
        for (int ai = 0; ai < 2; ++ai)
#pragma unroll
            for (int m = 0; m < 4; ++m) { const int row = row0 + ai * HALF + m * 16; bf16_t* rowb = Cb + (size_t)row * DM + col0; float ss = 0.f;
#pragma unroll
                for (int bj = 0; bj < 2; ++bj) { const f32x4 v0 = acc[ai][bj][m][0], v1 = acc[ai][bj][m][1];
                    u32x4 w; w.x = cvt_pk_bf16(v0[0], v0[1]); w.y = cvt_pk_bf16(v0[2], v0[3]); w.z = cvt_pk_bf16(v1[0], v1[1]); w.w = cvt_pk_bf16(v1[2], v1[3]);
                    *(u32x4*)(rowb + bj * HALF) = w;
                    ss += v0[0] * v0[0] + v0[1] * v0[1] + v0[2] * v0[2] + v0[3] * v0[3] + v1[0] * v1[0] + v1[1] * v1[1] + v1[2] * v1[2] + v1[3] * v1[3]; }
                ss += __shfl_xor(ss, 16, 64);
                { const u32x2 sw = __builtin_amdgcn_permlane32_swap(__float_as_uint(ss), __float_as_uint(ss), false, false); ss = __uint_as_float(sw[0]) + __uint_as_float(sw[1]); }
                if (fq == 0) red[(wr * 64 + fr + ai * HALF + m * 16) * 4 + wc] = ss; }
        asm volatile("s_waitcnt lgkmcnt(0)" ::: "memory"); __builtin_amdgcn_s_barrier(); asm volatile("" ::: "memory");
        if (wc == 0 && fq == 0) {
#pragma unroll
            for (int ai = 0; ai < 2; ++ai)
#pragma unroll
                for (int m = 0; m < 4; ++m) { const int rl = wr * 64 + fr + ai * HALF + m * 16; const f32x4 v = *(const LAS f32x4*)(red + rl * 4);
                    ssq[(size_t)(u.pm * BM + rl) * 4 + u.pn] = (v[0] + v[1]) + (v[2] + v[3]); }
        }
    }
};
template <int ACT  > struct EpiBf16 {
    static constexpr bool PERM = true;
    bf16_t* O; int ldc; const float* ssq; LAS float* rsl; float2* stat; LAS float* red2;
    __device__ __forceinline__ void init(f32x4 (&acc)[2][2][4][2], const Unit& u, int wr, int wc, int fr, int fq) const {
        {
            const float* src = ssq + (size_t)(u.pm * BM + wr * 64 + fq * 16 + fr) * 4;
            LAS unsigned char* dst = (LAS unsigned char*)rsl + (wr * 4 + wc) * 2048;
            __builtin_amdgcn_global_load_lds((const unsigned*)src, (LAS unsigned*)dst, 16, 0, 0);
            __builtin_amdgcn_global_load_lds((const unsigned*)(src + HALF * 4), (LAS unsigned*)(dst + 1024), 16, 0, 0);
        }
#pragma unroll
        for (int a = 0; a < 2; ++a)
#pragma unroll
            for (int b = 0; b < 2; ++b)
#pragma unroll
                for (int m = 0; m < 4; ++m)
#pragma unroll
                    for (int n = 0; n < 2; ++n) acc[a][b][m][n] = (f32x4){0.f, 0.f, 0.f, 0.f};
    }
    __device__ __forceinline__ void operator()(const f32x4 (&acc)[2][2][4][2], const Unit& u, int wr, int wc, int fr, int fq) const {
        const int row0 = u.pm * BM + wr * 64 + fr, col0 = u.pn * BM + wc * 32 + 8 * fq;
        const bool dost = (ACT == 1) && u.pn >= 8;
#pragma unroll
        for (int ai = 0; ai < 2; ++ai)
#pragma unroll
            for (int m = 0; m < 4; ++m) { const int row = row0 + ai * HALF + m * 16; bf16_t* rowp = O + (size_t)row * ldc + col0;
                const f32x4 s4 = *(const LAS f32x4*)((const LAS unsigned char*)rsl + (wr * 4 + wc) * 2048 + ai * 1024 + (m * 16 + fr) * 16);
                const float rs = __builtin_amdgcn_rsqf(((s4[0] + s4[1]) + (s4[2] + s4[3])) * (1.0f / 1024.0f) + 1e-6f);
                float s1 = 0.f, s2 = 0.f;
#pragma unroll
                for (int bj = 0; bj < 2; ++bj) { f32x4 v0, v1;
                    if (ACT == 2) { const f32x4 a0 = acc[ai][bj][m][0], a1 = acc[ai][bj][m][1], z4 = (f32x4){0.f, 0.f, 0.f, 0.f}; const float rs2 = rs * rs;
                        v0 = (a0 * __builtin_elementwise_max(a0, z4)) * rs2; v1 = (a1 * __builtin_elementwise_max(a1, z4)) * rs2; }
                    else { v0 = acc[ai][bj][m][0] * rs; v1 = acc[ai][bj][m][1] * rs; }
                    if (ACT == 1) { f32x2 a = gelu_pk((f32x2){v0[0], v0[1]}), b = gelu_pk((f32x2){v0[2], v0[3]}), c = gelu_pk((f32x2){v1[0], v1[1]}), d = gelu_pk((f32x2){v1[2], v1[3]});
                        v0 = (f32x4){a.x, a.y, b.x, b.y}; v1 = (f32x4){c.x, c.y, d.x, d.y};
                        s1 += ((v0[0] + v0[1]) + (v0[2] + v0[3])) + ((v1[0] + v1[1]) + (v1[2] + v1[3]));
                        s2 += ((v0[0] * v0[0] + v0[1] * v0[1]) + (v0[2] * v0[2] + v0[3] * v0[3])) + ((v1[0] * v1[0] + v1[1] * v1[1]) + (v1[2] * v1[2] + v1[3] * v1[3])); }
                    u32x4 w; w.x = cvt_pk_bf16(v0[0], v0[1]); w.y = cvt_pk_bf16(v0[2], v0[3]); w.z = cvt_pk_bf16(v1[0], v1[1]); w.w = cvt_pk_bf16(v1[2], v1[3]);
                    *(u32x4*)(rowp + bj * HALF) = w; }
                if (ACT == 1) { if (dost) { s1 += __shfl_xor(s1, 16, 64); s1 += __shfl_xor(s1, 32, 64); s2 += __shfl_xor(s2, 16, 64); s2 += __shfl_xor(s2, 32, 64);
                    if (fq == 0) { LAS float* rp = red2 + ((wr * 64 + fr + ai * HALF + m * 16) * 4 + wc) * 2; rp[0] = s1; rp[1] = s2; } } } }
        if (ACT == 1) { if (dost) {
            asm volatile("s_waitcnt lgkmcnt(0)" ::: "memory"); __builtin_amdgcn_s_barrier(); asm volatile("" ::: "memory");
            if (wc == 0 && fq == 0) {
#pragma unroll
                for (int ai = 0; ai < 2; ++ai)
#pragma unroll
                    for (int m = 0; m < 4; ++m) { const int rl = wr * 64 + fr + ai * HALF + m * 16; const f32x4 a = *(const LAS f32x4*)(red2 + rl * 8), b = *(const LAS f32x4*)(red2 + rl * 8 + 4);
                        stat[(size_t)(u.pm * BM + rl) * 8 + (u.pn - 8)] = make_float2((a[0] + a[2]) + (b[0] + b[2]), (a[1] + a[3]) + (b[1] + b[3])); }
            } } }
    }
};

template <class Epi>
__device__ __forceinline__ void gemm_phase(LAS unsigned char* lds, const Gemm g, const StaticOrder& S, const Epi& E) {
    const int tid = tid_opaque(), wid = __builtin_amdgcn_readfirstlane(tid >> 6), lane = tid & 63, wr = wid >> 2, wc = wid & 3, fr = lane & 15, fq = lane >> 4;
    const int K = g.K, nt = K / BK, lda = g.lda;
    unsigned voffA[2], voffB[2];
#pragma unroll
    for (int i = 0; i < 2; ++i) { int R, C; stage_rc(tid * 16 + i * 8192, R, C); const int Rb = Epi::PERM ? ((R & ~31) + perm32(R & 31)) : R;
        voffA[i] = (unsigned)(R * lda + C) * 2u; voffB[i] = (unsigned)(Rb * K + C) * 2u; }
    const size_t kstep = (size_t)(BK * 2);
    const size_t hstepA = (size_t)HALF * lda * 2, hstepB = (size_t)HALF * K * 2;
    const size_t tstepA = 2 * hstepA, tstepB = 2 * hstepB;
    const unsigned ldsw = (unsigned)wid * 1024u;
    const int aoff = lds_byte(wr * 64 + fr, fq * 8), boff = lds_byte(wc * 32 + fr, fq * 8);
#define PG8_SA(b, h) (((b) * 2 + (h)) * HTB)
#define PG8_SB(b, h) ((4 + (b) * 2 + (h)) * HTB)
#define PG8_STAGE(bufoff, gbase, voff) do { _Pragma("unroll") for (int _i = 0; _i < 2; ++_i) \
        __builtin_amdgcn_global_load_lds((const unsigned*)((const char*)(gbase) + (voff)[_i]), (LAS unsigned*)(lds + (bufoff) + ldsw + _i * 8192), 16, 0, 0); } while (0)
#define PG8_LDA(dst, b, h) do { _Pragma("unroll") for (int m = 0; m < 4; ++m) _Pragma("unroll") for (int k = 0; k < 2; ++k) dst[m][k] = *(const LAS bf16x8*)(lds + PG8_SA(b, h) + aoff + m * 2048 + k * 1024); } while (0)
#define PG8_LDB(dst, b, h) do { _Pragma("unroll") for (int n = 0; n < 2; ++n) _Pragma("unroll") for (int k = 0; k < 2; ++k) dst[n][k] = *(const LAS bf16x8*)(lds + PG8_SB(b, h) + boff + n * 2048 + k * 1024); } while (0)
#define PG8_MMA(ai, bj, At, Bt) do { __builtin_amdgcn_s_setprio(1); _Pragma("unroll") for (int m = 0; m < 4; ++m) _Pragma("unroll") for (int n = 0; n < 2; ++n) _Pragma("unroll") for (int k = 0; k < 2; ++k) \
        acc[ai][bj][m][n] = __builtin_amdgcn_mfma_f32_16x16x32_bf16(Bt[n][k], At[m][k], acc[ai][bj][m][n], 0, 0, 0); __builtin_amdgcn_s_setprio(0); } while (0)
#define PG8_WAIT_V(n) asm volatile("s_waitcnt vmcnt(" #n ")" ::: "memory")
#define PG8_WAIT_L(n) asm volatile("s_waitcnt lgkmcnt(" #n ")" ::: "memory")
#define PG8_BAR __builtin_amdgcn_s_barrier()
#define PG8_SCHED __builtin_amdgcn_sched_barrier(0)
    Unit cur, nxt; int ui = 0;
    if (!S.next(0, cur)) return;
    f32x4 acc[2][2][4][2];
    E.init(acc, cur, wr, wc, fr, fq);
    bf16x8 At[4][2], B0[2][2], B1[2][2];
    const char* cA = (const char*)g.A + (size_t)cur.pm * tstepA; const char* cB = (const char*)g.Bt + (size_t)cur.pn * tstepB;
    PG8_STAGE(PG8_SB(0, 0), cB, voffB); PG8_STAGE(PG8_SB(0, 1), cB + hstepB, voffB); PG8_STAGE(PG8_SA(0, 0), cA, voffA); PG8_STAGE(PG8_SA(0, 1), cA + hstepA, voffA);
    if (wr == 1) PG8_BAR;
    PG8_WAIT_V(2); PG8_BAR;
    PG8_STAGE(PG8_SB(1, 0), cB + kstep, voffB); PG8_STAGE(PG8_SA(1, 0), cA + kstep, voffA); PG8_STAGE(PG8_SB(1, 1), cB + hstepB + kstep, voffB);
    PG8_WAIT_V(6); PG8_BAR;
    for (;;) {
        const bool has_next = S.next(ui + 1, nxt);
        const char* nA = has_next ? (const char*)g.A + (size_t)nxt.pm * tstepA : cA; const char* nB = has_next ? (const char*)g.Bt + (size_t)nxt.pn * tstepB : cB;
        for (int t = 0; t < nt; t += 2) {
            const bool last = (t == nt - 2);
            const char* a1 = cA + (size_t)(t + 1) * kstep;
            const char* a2 = last ? nA : cA + (size_t)(t + 2) * kstep; const char* b2 = last ? nB : cB + (size_t)(t + 2) * kstep;
            const char* a3 = a2 + kstep; const char* b3 = b2 + kstep;
            PG8_LDB(B0, 0, 0); PG8_LDB(B1, 0, 1); PG8_SCHED; PG8_LDA(At, 0, 0); PG8_STAGE(PG8_SA(1, 1), a1 + hstepA, voffA);
            PG8_WAIT_V(8); PG8_WAIT_L(0); PG8_BAR; PG8_MMA(0, 0, At, B0); PG8_MMA(0, 1, At, B1); PG8_BAR; PG8_SCHED;
            PG8_LDA(At, 0, 1); PG8_STAGE(PG8_SB(0, 0), b2, voffB); PG8_STAGE(PG8_SB(0, 1), b2 + hstepB, voffB); PG8_STAGE(PG8_SA(0, 0), a2, voffA);
            PG8_WAIT_V(8); PG8_WAIT_L(0); PG8_BAR; PG8_MMA(1, 0, At, B0); PG8_MMA(1, 1, At, B1); PG8_BAR; PG8_SCHED;
            PG8_LDB(B0, 1, 0); PG8_LDB(B1, 1, 1); PG8_SCHED; PG8_LDA(At, 1, 0); PG8_STAGE(PG8_SA(0, 1), a2 + hstepA, voffA);
            PG8_WAIT_V(8); PG8_WAIT_L(0); PG8_BAR; PG8_MMA(0, 0, At, B0); PG8_MMA(0, 1, At, B1); PG8_BAR; PG8_SCHED;
            PG8_LDA(At, 1, 1); PG8_STAGE(PG8_SB(1, 0), b3, voffB); PG8_STAGE(PG8_SB(1, 1), b3 + hstepB, voffB); PG8_STAGE(PG8_SA(1, 0), a3, voffA);
            PG8_WAIT_V(8); PG8_WAIT_L(0); PG8_BAR; PG8_MMA(1, 0, At, B0); PG8_MMA(1, 1, At, B1); PG8_BAR; PG8_SCHED;
        }
        if (wr == 0) PG8_BAR;
        E(acc, cur, wr, wc, fr, fq);
        if (!has_next) break;
        E.init(acc, nxt, wr, wc, fr, fq);
        cur = nxt; cA = nA; cB = nB; ++ui;
        if (wr == 1) PG8_BAR;
    }
    PG8_WAIT_V(0);
    PG8_BAR;
#undef PG8_SA
#undef PG8_SB
#undef PG8_STAGE
#undef PG8_LDA
#undef PG8_LDB
#undef PG8_MMA
#undef PG8_WAIT_V
#undef PG8_WAIT_L
#undef PG8_BAR
#undef PG8_SCHED
}
}

__device__ __forceinline__ int rel_bucket(int rel) {
    const int n = rel < 0 ? -rel : rel;
    const int b = n < 8 ? n : (8 + (n >= 15) + (n >= 27) + (n >= 50) + (n >= 91) + (n >= 166) + (n >= 305) + (n >= 559));
    return (rel > 0 ? 16 : 0) + b;
}

__device__ void convert_T(const float* __restrict__ src, bf16_t* __restrict__ dst, int K, int N, float* tile, const float* __restrict__ gk = nullptr) {
    const int tn = N / 64, nt = (K / 64) * tn, tid = tid_opaque();
    for (int t = blockIdx.x; t < nt; t += gridDim.x) {
        const int k0 = (t / tn) * 64, n0 = (t % tn) * 64;
        for (int idx = tid; idx < 1024; idx += 512) {
            const int kk = idx >> 4, n4 = (idx & 15) * 4;
            const float4 v = *(const float4*)(src + (size_t)(k0 + kk) * N + n0 + n4);
            const float gg = gk ? gk[k0 + kk] : 1.0f;
            float* tp = tile + kk * 65 + n4; tp[0] = v.x * gg; tp[1] = v.y * gg; tp[2] = v.z * gg; tp[3] = v.w * gg;
        }
        __syncthreads();
        {
            const int nn = tid >> 3, kk0 = (tid & 7) * 8;
            const float* tp = tile + kk0 * 65 + nn;
            uint4 w; w.x = pack2(tp[0], tp[65]); w.y = pack2(tp[130], tp[195]); w.z = pack2(tp[260], tp[325]); w.w = pack2(tp[390], tp[455]);
            *(uint4*)(dst + (size_t)(n0 + nn) * K + k0 + kk0) = w;
        }
        __syncthreads();
    }
}

__device__ void phase_norm(const Params& p, const float* __restrict__ src  , const float* __restrict__ g, bf16_t* __restrict__ H, float* __restrict__ Xc, float* __restrict__ Fout) {
    const int tid = tid_opaque(), lane = tid & 63, gw = blockIdx.x * 8 + (tid >> 6), nw = gridDim.x * 8;
    float4 gv[4];
#pragma unroll
    for (int k = 0; k < 4; ++k) gv[k] = *(const float4*)(g + lane * 4 + 256 * k);
    for (int r = gw; r < T_TOK; r += nw) {
        const float* row = src ? src + (size_t)r * DM : (r < 32768 ? p.x_prompt + (size_t)r * DM : p.x_sample + (size_t)(r - 32768) * DM);
        float4 v[4]; float ss = 0.f;
#pragma unroll
        for (int k = 0; k < 4; ++k) { v[k] = *(const float4*)(row + lane * 4 + 256 * k); ss += v[k].x * v[k].x + v[k].y * v[k].y + v[k].z * v[k].z + v[k].w * v[k].w; }
        ss = wave_sum(ss);
        const float rstd = 1.0f / sqrtf(ss * (1.0f / 1024.0f) + 1e-6f);
#pragma unroll
        for (int k = 0; k < 4; ++k) {
            const float a = v[k].x * rstd * gv[k].x, b = v[k].y * rstd * gv[k].y, c = v[k].z * rstd * gv[k].z, d = v[k].w * rstd * gv[k].w;
            if (H) { uint2 w; w.x = pack2(a, b); w.y = pack2(c, d); *(uint2*)(H + (size_t)r * DM + lane * 4 + 256 * k) = w; }
            if (Xc) *(float4*)(Xc + (size_t)r * DM + lane * 4 + 256 * k) = v[k];
            if (Fout) *(float4*)(Fout + (size_t)r * DM + lane * 4 + 256 * k) = make_float4(a, b, c, d);
        }
    }
}


__device__ void phase_prep_x(const Params& p, bf16_t* __restrict__ Xb, float* __restrict__ ssq) {
    const int tid = tid_opaque(), lane = tid & 63, gw = blockIdx.x * 8 + (tid >> 6), nw = gridDim.x * 8;
    for (int r = gw; r < T_TOK; r += nw) {
        const float* row = r < 32768 ? p.x_prompt + (size_t)r * DM : p.x_sample + (size_t)(r - 32768) * DM;
        float ss = 0.f;
#pragma unroll
        for (int k = 0; k < 4; ++k) { const float4 v = *(const float4*)(row + lane * 4 + 256 * k); ss += v.x * v.x + v.y * v.y + v.z * v.z + v.w * v.w;
            uint2 w; w.x = pack2(v.x, v.y); w.y = pack2(v.z, v.w); *(uint2*)(Xb + (size_t)r * DM + lane * 4 + 256 * k) = w; }
        ss = wave_sum(ss);
        if (lane < 4) ssq[(size_t)r * 4 + lane] = lane == 0 ? ss : 0.f;
    }
}

__device__ void phase_final(const bf16_t* __restrict__ Xb, const float* __restrict__ g, float* __restrict__ out) {
    const int tid = tid_opaque(), lane = tid & 63, gw = blockIdx.x * 8 + (tid >> 6), nw = gridDim.x * 8;
    for (int r = gw; r < T_TOK; r += nw) {
        float x[16]; float ss = 0.f;
#pragma unroll
        for (int k = 0; k < 2; ++k) { const uint4 w = *(const uint4*)(Xb + (size_t)r * DM + lane * 8 + 512 * k);
            x[8 * k + 0] = bflo(w.x); x[8 * k + 1] = bfhi(w.x); x[8 * k + 2] = bflo(w.y); x[8 * k + 3] = bfhi(w.y);
            x[8 * k + 4] = bflo(w.z); x[8 * k + 5] = bfhi(w.z); x[8 * k + 6] = bflo(w.w); x[8 * k + 7] = bfhi(w.w); }
#pragma unroll
        for (int k = 0; k < 16; ++k) ss += x[k] * x[k];
        ss = wave_sum(ss);
        const float rstd = 1.0f / sqrtf(ss * (1.0f / 1024.0f) + 1e-6f);
#pragma unroll
        for (int k = 0; k < 2; ++k) {
            const float4 g0 = *(const float4*)(g + lane * 8 + 512 * k), g1 = *(const float4*)(g + lane * 8 + 512 * k + 4);
            float* op = out + (size_t)r * DM + lane * 8 + 512 * k;
            *(float4*)op = make_float4(x[8 * k] * rstd * g0.x, x[8 * k + 1] * rstd * g0.y, x[8 * k + 2] * rstd * g0.z, x[8 * k + 3] * rstd * g0.w);
            *(float4*)(op + 4) = make_float4(x[8 * k + 4] * rstd * g1.x, x[8 * k + 5] * rstd * g1.y, x[8 * k + 6] * rstd * g1.z, x[8 * k + 7] * rstd * g1.w);
        }
    }
}
__device__ __forceinline__ void zero_f32(float* p, int n) { for (int i = blockIdx.x * 512 + tid_opaque(); i < n; i += gridDim.x * 512) p[i] = 0.f; }

__device__ void phase_attn_naive(const bf16_t* __restrict__ qkv, int ld, int ngroups, const float* __restrict__ rel_bias, const float* __restrict__ sink, bf16_t* __restrict__ out, int ntok) {
    const int tid = tid_opaque(), lane = tid & 63, gw = blockIdx.x * 8 + (tid >> 6), nw = gridDim.x * 8;
    for (int item = gw; item < ntok * 16; item += nw) {
        const int tok = item >> 4, h = item & 15, g = h >> 2;
        const int i = tok & (SEQ - 1), seqbase = tok - i;
        float m = sink ? sink[h] : -INFINITY, l = sink ? 1.f : 0.f, o = 0.f;
        for (int gi = 0; gi < ngroups; ++gi) {
            const int dil = ngroups == 1 ? 1 : (gi == 0 ? 1 : (gi == 1 ? 4 : 16));
            const int R = ngroups == 1 ? 128 : 64;
            const int L = SEQ / dil, t = i / dil, r = i % dil;
            const bf16_t* base = qkv + (size_t)gi * 1536;
            const float qv = bf2f(base[(size_t)tok * ld + h * 64 + lane]) * 0.125f;
            const int nb = (2 * R + 1 + 63) / 64;
            for (int b = 0; b < nb; ++b) {
                const int tp = t - R + 64 * b + lane;
                const bool valid = tp >= 0 && tp < L && tp <= t + R;
                const int tpc = min(max(tp, 0), L - 1);
                const uint4* kp = (const uint4*)(base + (size_t)(seqbase + tpc * dil + r) * ld + 1024 + g * 64);
                float s = 0.f;
#pragma unroll
                for (int c = 0; c < 8; ++c) {
                    const uint4 kv = kp[c];
                    s += rdlane(qv, c * 8 + 0) * bflo(kv.x) + rdlane(qv, c * 8 + 1) * bfhi(kv.x);
                    s += rdlane(qv, c * 8 + 2) * bflo(kv.y) + rdlane(qv, c * 8 + 3) * bfhi(kv.y);
                    s += rdlane(qv, c * 8 + 4) * bflo(kv.z) + rdlane(qv, c * 8 + 5) * bfhi(kv.z);
                    s += rdlane(qv, c * 8 + 6) * bflo(kv.w) + rdlane(qv, c * 8 + 7) * bfhi(kv.w);
                }
                s += rel_bias[rel_bucket((tp - t) * dil) * 16 + h];
                s = valid ? s : -INFINITY;
                const float bm = wave_max(s);
                if (bm == -INFINITY) continue;
                const float mn = fmaxf(m, bm);
                const float sc = __expf(m - mn);
                const float pe = valid ? __expf(s - mn) : 0.f;
                l = l * sc + wave_sum(pe);
                o *= sc;
                const int tb = t - R + 64 * b;
                for (int j = 0; j < 64; ++j) {
                    const float pj = rdlane(pe, j);
                    const int tj = min(max(tb + j, 0), L - 1);
                    o += pj * bf2f(base[(size_t)(seqbase + tj * dil + r) * ld + 1280 + g * 64 + lane]);
                }
                m = mn;
            }
        }
        out[(size_t)tok * DM + h * 64 + lane] = f2bf(o / l);
    }
}

__device__ void phase_b_stats(const bf16_t* __restrict__ Z, float2* __restrict__ stats) {
    const int tid = tid_opaque(), lane = tid & 63, gw = blockIdx.x * 8 + (tid >> 6), nw = gridDim.x * 8;
    for (int r = gw; r < CHK; r += nw) {
        const uint4* vp = (const uint4*)(Z + (size_t)r * 4096 + 2048);
        float x[32]; float s = 0.f;
#pragma unroll
        for (int k = 0; k < 4; ++k) { const uint4 w = vp[lane + 64 * k];
            x[k * 8 + 0] = bflo(w.x); x[k * 8 + 1] = bfhi(w.x); x[k * 8 + 2] = bflo(w.y); x[k * 8 + 3] = bfhi(w.y);
            x[k * 8 + 4] = bflo(w.z); x[k * 8 + 5] = bfhi(w.z); x[k * 8 + 6] = bflo(w.w); x[k * 8 + 7] = bfhi(w.w); }
#pragma unroll
        for (int k = 0; k < 32; ++k) s += x[k];
        const float mu = wave_sum(s) * (1.0f / 2048.0f);
        float q = 0.f;
#pragma unroll
        for (int k = 0; k < 32; ++k) { const float d = x[k] - mu; q += d * d; }
        const float var = wave_sum(q) * (1.0f / 2048.0f);
        if (lane == 0) stats[r] = make_float2(mu, 1.0f / sqrtf(var + 1e-5f));
    }
}

__device__ void phase_b_mix_naive(const Params& p, bf16_t* __restrict__ Z, const float2* __restrict__ stats, float* vln  ) {
    const int tid = tid_opaque();
    for (int unit = blockIdx.x; unit < 128 * 16; unit += gridDim.x) {
        const int tc = unit >> 4, cb = unit & 15, g = cb >> 1;
        for (int piece = tid; piece < 2048; piece += 512) {
            const int q = piece >> 4, c8 = (piece & 15) * 8;
            const int tok = tc * 128 + q, ch = cb * 128 + c8;
            const uint4 w = *(const uint4*)(Z + (size_t)tok * 4096 + 2048 + ch);
            const float2 st = stats[tok];
            const float4 g0 = *(const float4*)(p.b_ln_g + ch), g1 = *(const float4*)(p.b_ln_g + ch + 4), b0 = *(const float4*)(p.b_ln_b + ch), b1 = *(const float4*)(p.b_ln_b + ch + 4);
            float* d = vln + q * 128 + c8;
            d[0] = (bflo(w.x) - st.x) * st.y * g0.x + b0.x; d[1] = (bfhi(w.x) - st.x) * st.y * g0.y + b0.y;
            d[2] = (bflo(w.y) - st.x) * st.y * g0.z + b0.z; d[3] = (bfhi(w.y) - st.x) * st.y * g0.w + b0.w;
            d[4] = (bflo(w.z) - st.x) * st.y * g1.x + b1.x; d[5] = (bfhi(w.z) - st.x) * st.y * g1.y + b1.y;
            d[6] = (bflo(w.w) - st.x) * st.y * g1.z + b1.z; d[7] = (bfhi(w.w) - st.x) * st.y * g1.w + b1.w;
        }
        __syncthreads();
        const int ch = tid & 127, pq = tid >> 7;
        for (int pp = 0; pp < 32; pp += 4) {
            const int p0 = pq * 32 + pp;
            const float* w0 = p.b_ws + (size_t)(g * 128 + p0) * 128;
            float a0 = 0.f, a1 = 0.f, a2 = 0.f, a3 = 0.f;
            for (int q = 0; q < 128; ++q) {
                const float v = vln[q * 128 + ch];
                a0 += w0[q] * v; a1 += w0[128 + q] * v; a2 += w0[256 + q] * v; a3 += w0[384 + q] * v;
            }
            const float acc[4] = {a0, a1, a2, a3};
#pragma unroll
            for (int k = 0; k < 4; ++k) {
                const int pr = p0 + k;
                bf16_t* up = Z + (size_t)(tc * 128 + pr) * 4096 + cb * 128 + ch;
                *up = f2bf(bf2f(*up) * (acc[k] + p.b_bs[g * 128 + pr]));
            }
        }
        __syncthreads();
    }
}


typedef float f32x16 __attribute__((ext_vector_type(16)));
typedef short s16x4 __attribute__((ext_vector_type(4)));
__device__ __forceinline__ unsigned lds_off(const LAS void* p) { return (unsigned)(__UINTPTR_TYPE__)p; }
__device__ __forceinline__ bf16x8 tr_read2(unsigned a0, unsigned a1) {
    s16x4 r0, r1;
    asm volatile("ds_read_b64_tr_b16 %0, %2\n\tds_read_b64_tr_b16 %1, %3\n\ts_waitcnt lgkmcnt(0)" : "=&v"(r0), "=&v"(r1) : "v"(a0), "v"(a1) : "memory");
    bf16x8 r; r[0] = r0[0]; r[1] = r0[1]; r[2] = r0[2]; r[3] = r0[3]; r[4] = r1[0]; r[5] = r1[1]; r[6] = r1[2]; r[7] = r1[3]; return r;
}
constexpr int AT_KS = 144, AT_VS = 192, AT_BT = 324, AT_NKMAX = 384;
#define TR_ISSUE8(va, a0, a1, b0, b1, c0, c1, d0, d1) \
    asm volatile("ds_read_b64_tr_b16 %0, %8\n\tds_read_b64_tr_b16 %1, %8 offset:1536\n\tds_read_b64_tr_b16 %2, %8 offset:64\n\tds_read_b64_tr_b16 %3, %8 offset:1600\n\t" \
                 "ds_read_b64_tr_b16 %4, %8 offset:3072\n\tds_read_b64_tr_b16 %5, %8 offset:4608\n\tds_read_b64_tr_b16 %6, %8 offset:3136\n\tds_read_b64_tr_b16 %7, %8 offset:4672" \
                 : "=&v"(a0), "=&v"(a1), "=&v"(b0), "=&v"(b1), "=&v"(c0), "=&v"(c1), "=&v"(d0), "=&v"(d1) : "v"(va))
#define TR_WAIT8(a0, a1, b0, b1, c0, c1, d0, d1) \
    asm volatile("s_waitcnt lgkmcnt(0)" : "+v"(a0), "+v"(a1), "+v"(b0), "+v"(b1), "+v"(c0), "+v"(c1), "+v"(d0), "+v"(d1))
__device__ __forceinline__ bf16x8 cat4(s16x4 lo, s16x4 hi) { bf16x8 r; r[0] = lo[0]; r[1] = lo[1]; r[2] = lo[2]; r[3] = lo[3]; r[4] = hi[0]; r[5] = hi[1]; r[6] = hi[2]; r[7] = hi[3]; return r; }
static_assert(AT_NKMAX * (AT_KS + AT_VS) <= 131072 && 4 * AT_BT * 4 <= 16384, "attention LDS map");
static_assert(AT_VS == 192, "tr_read8 immediates: 8 rows = 1536 B, 16 rows = 3072 B, 24 rows = 4608 B");
__device__ __forceinline__ void phase_attn(const bf16_t* __restrict__ qkv, int ld, bool isC, const float* __restrict__ rel_bias, const float* __restrict__ sink,
                           bf16_t* __restrict__ out, bf16_t* __restrict__ out12, float* __restrict__ lse, LAS unsigned char* lds) {
    const int tid = tid_opaque(), lane = tid & 63, wid = __builtin_amdgcn_readfirstlane(tid >> 6), n = lane & 31, hf = lane >> 5;
    const int R = isC ? 64 : 128, NK = 128 + 2 * R, NT = R / 16 + 1;
    LAS unsigned char* Ks = lds; LAS unsigned char* Vs = lds + AT_NKMAX * AT_KS; LAS float* bT = (LAS float*)(lds + 131072 + 16 + 4096);
    const float L2E = 1.4426950408889634f;
    const int hl = wid >> 1, sb2 = wid & 1;
    int bias_key = -1;
    const int cw = ((gridDim.x & 7) == 0) ? (int)((blockIdx.x & 7) * (gridDim.x >> 3) + (blockIdx.x >> 3)) : (int)blockIdx.x;
    const bool cmap = gridDim.x == 256;
    const int nit = cmap ? 6 : (1536 - cw + (int)gridDim.x - 1) / (int)gridDim.x;
    for (int itu = 0; itu < nit; ++itu) {
        int u = cw + itu * (int)gridDim.x;
        if (cmap) { const int x = (int)(blockIdx.x & 7), rw = (int)(blockIdx.x >> 3), gq = rw >> 3, idx = (rw & 7) + 8 * itu;
            u = isC ? ((idx >> 4) * 512 + x * 64 + gq * 16 + (idx & 15)) : ((3 * x + (idx >> 4)) * 64 + gq * 16 + (idx & 15)); }
        int gi = 0, dil = 1, seq, g, r = 0, tb;
        if (isC) { gi = u >> 9; const int rem = u & 511; seq = rem >> 6; g = (rem >> 4) & 3; const int rb = rem & 15; dil = gi == 0 ? 1 : (gi == 1 ? 4 : 16); r = rb & (dil - 1); tb = rb / dil; }
        else { seq = u >> 6; g = (u >> 4) & 3; tb = u & 15; }
        const int L = SEQ / dil, t0 = tb * 128;
        const bf16_t* base = qkv + (size_t)gi * 1536;
        const size_t seqbase = (size_t)seq * SEQ;
        __syncthreads();
        {
            u32x4 kreg[6], vreg[6];
#pragma unroll
            for (int it = 0; it < 6; ++it) {
                const int idx = tid + 512 * it, row = idx >> 3, pc = idx & 7, tp = t0 - R + row;
                kreg[it] = (u32x4){0u, 0u, 0u, 0u}; vreg[it] = kreg[it];
                if (idx < NK * 8 && tp >= 0 && tp < L) { const bf16_t* src = base + (seqbase + (size_t)tp * dil + r) * ld + 1024 + g * 64 + pc * 8; kreg[it] = *(const u32x4*)src; vreg[it] = *(const u32x4*)(src + 256); }
            }
#pragma unroll
            for (int it = 0; it < 6; ++it) {
                const int idx = tid + 512 * it, row = idx >> 3, pc = idx & 7;
                if (idx < NK * 8) { *(LAS u32x4*)(Ks + row * AT_KS + pc * 16) = kreg[it]; *(LAS u32x4*)(Vs + row * AT_VS + pc * 16) = vreg[it]; }
            }
        }
        if (bias_key != gi * 4 + g) {
            bias_key = gi * 4 + g;
            for (int idx = tid; idx < 4 * AT_BT; idx += 512) {
                const int h4 = idx / AT_BT, rel = idx - h4 * AT_BT - 32;
                float v = -INFINITY;
                if (rel >= 0 && rel <= 2 * R) v = rel_bias[rel_bucket((rel - R) * dil) * 16 + g * 4 + h4] * L2E;
                bT[idx] = v;
            }
        }
        __syncthreads();
        const int hh = g * 4 + hl;
        const unsigned vlane = lds_off(Vs) + (unsigned)((4 * hf + ((lane & 15) >> 2)) * AT_VS + (16 * ((lane >> 4) & 1) + 4 * (lane & 3)) * 2);
        for (int j = 0; j < 2; ++j) {
            const int qb = sb2 * 2 + j;
            const int tq = t0 + 32 * qb + n;
            const size_t qtok = seqbase + (size_t)tq * dil + r;
            const bf16_t* qp = base + qtok * ld + hh * 64 + 8 * hf;
            bf16x8 qf[4];
#pragma unroll
            for (int ks = 0; ks < 4; ++ks) qf[ks] = *(const bf16x8*)(qp + 16 * ks);
            f32x16 o0, o1;
#pragma unroll
            for (int i = 0; i < 16; ++i) { o0[i] = 0.f; o1[i] = 0.f; }
            float m = -INFINITY, l = 0.f;
            if (sink) { m = sink[hh] * L2E; l = hf == 0 ? 1.f : 0.f; }
            const LAS float* bp = bT + hl * AT_BT + 32 - n + 4 * hf;
            const int tbase = t0 + 32 * qb - R;
            const int kt_lo = tbase < 0 ? (-tbase) >> 5 : 0, kt_hi = min(NT - 1, (L - 32 - tbase) >> 5);
            f32x16 sn;
            {
#pragma unroll
                for (int i = 0; i < 16; ++i) sn[i] = 0.f;
                const LAS unsigned char* kr = Ks + (32 * qb + 32 * kt_lo + n) * AT_KS + 16 * hf;
#pragma unroll
                for (int ks = 0; ks < 4; ++ks) sn = __builtin_amdgcn_mfma_f32_32x32x16_bf16(*(const LAS bf16x8*)(kr + 32 * ks), qf[ks], sn, 0, 0, 0);
            }
            for (int kt = kt_lo; kt <= kt_hi; ++kt) {
                const int rowb = 32 * qb + 32 * kt;
                f32x16 s = sn;
                s16x4 ta0, ta1, tb0, tb1, tc0, tc1, td0, td1;
                { const unsigned va = vlane + (unsigned)(rowb * AT_VS); TR_ISSUE8(va, ta0, ta1, tb0, tb1, tc0, tc1, td0, td1); }
                {
                    const int ktn = min(kt + 1, kt_hi);
#pragma unroll
                    for (int i = 0; i < 16; ++i) sn[i] = 0.f;
                    const LAS unsigned char* kr = Ks + (32 * qb + 32 * ktn + n) * AT_KS + 16 * hf;
#pragma unroll
                    for (int ks = 0; ks < 4; ++ks) sn = __builtin_amdgcn_mfma_f32_32x32x16_bf16(*(const LAS bf16x8*)(kr + 32 * ks), qf[ks], sn, 0, 0, 0);
                }
                float mx = -INFINITY;
                {
                    const f32x2 c2 = (f32x2){0.125f * L2E, 0.125f * L2E};
#pragma unroll
                    for (int k = 0; k < 8; ++k) { const int i = 2 * k; const LAS float* bq = bp + 32 * kt + (i & 3) + 8 * (i >> 2);
                        f32x2 v = (f32x2){s[i], s[i + 1]} * c2 + (f32x2){bq[0], bq[1]}; s[i] = v.x; s[i + 1] = v.y; }
#pragma unroll
                    for (int i = 0; i < 16; ++i) mx = fmaxf(mx, s[i]);
                }
                mx = fmaxf(mx, __shfl_xor(mx, 32, 64));
                const float mn = fmaxf(m, mx);
                if (__any(mn > m + 8.0f)) {
                    const float sc = __builtin_amdgcn_exp2f(m - mn);
                    l *= sc;
#pragma unroll
                    for (int i = 0; i < 16; ++i) { o0[i] *= sc; o1[i] *= sc; }
                    m = mn;
                }
                {
                    const f32x2 m2 = (f32x2){m, m}; f32x2 ps2 = (f32x2){0.f, 0.f};
#pragma unroll
                    for (int k = 0; k < 8; ++k) { const int i = 2 * k; f32x2 v = (f32x2){s[i], s[i + 1]} - m2; v.x = __builtin_amdgcn_exp2f(v.x); v.y = __builtin_amdgcn_exp2f(v.y); ps2 += v; s[i] = v.x; s[i + 1] = v.y; }
                    l += ps2.x + ps2.y;
                }
                union { bf16x8 v; unsigned w[4]; } pf0, pf1;
#pragma unroll
                for (int jj = 0; jj < 4; ++jj) { pf0.w[jj] = pg8::cvt_pk_bf16(s[2 * jj], s[2 * jj + 1]); pf1.w[jj] = pg8::cvt_pk_bf16(s[8 + 2 * jj], s[8 + 2 * jj + 1]); }
                TR_WAIT8(ta0, ta1, tb0, tb1, tc0, tc1, td0, td1);
                o0 = __builtin_amdgcn_mfma_f32_32x32x16_bf16(cat4(ta0, ta1), pf0.v, o0, 0, 0, 0);
                o1 = __builtin_amdgcn_mfma_f32_32x32x16_bf16(cat4(tb0, tb1), pf0.v, o1, 0, 0, 0);
                o0 = __builtin_amdgcn_mfma_f32_32x32x16_bf16(cat4(tc0, tc1), pf1.v, o0, 0, 0, 0);
                o1 = __builtin_amdgcn_mfma_f32_32x32x16_bf16(cat4(td0, td1), pf1.v, o1, 0, 0, 0);
            }
            l += __shfl_xor(l, 32, 64);
            const float inv = 1.0f / l;
            bf16_t* op = (gi == 0 ? out : out12 + (size_t)(gi - 1) * CHK * 1024) + qtok * 1024 + hh * 64 + 4 * hf;
#pragma unroll
            for (int gq = 0; gq < 4; ++gq) {
                uint2 w0, w1;
                w0.x = pg8::cvt_pk_bf16(o0[4 * gq] * inv, o0[4 * gq + 1] * inv); w0.y = pg8::cvt_pk_bf16(o0[4 * gq + 2] * inv, o0[4 * gq + 3] * inv);
                w1.x = pg8::cvt_pk_bf16(o1[4 * gq] * inv, o1[4 * gq + 1] * inv); w1.y = pg8::cvt_pk_bf16(o1[4 * gq + 2] * inv, o1[4 * gq + 3] * inv);
                *(uint2*)(op + 8 * gq) = w0; *(uint2*)(op + 32 + 8 * gq) = w1;
            }
            if (isC && hf == 0) lse[((size_t)gi * CHK + qtok) * 16 + hh] = (m + __log2f(l)) * 0.6931471805599453f;
        }
    }
}

__device__ void phase_c_merge(const bf16_t* __restrict__ OG, const float* __restrict__ LSE, bf16_t* Hc) {
    const int tid = tid_opaque();
    const bool cmap = gridDim.x == 256;
    const int i0 = cmap ? (int)(blockIdx.x & 7) * 262144 + (int)(blockIdx.x >> 3) * 512 + tid : (int)blockIdx.x * 512 + tid;
    const int iend = cmap ? (int)(blockIdx.x & 7) * 262144 + 262144 : CHK * 128, istep = cmap ? 16384 : (int)gridDim.x * 512;
    for (int idx = i0; idx < iend; idx += istep) {
        const int tok = idx >> 7, c8 = (idx & 127) * 8, h = c8 >> 6;
        const float l0 = LSE[(size_t)tok * 16 + h], l1 = LSE[((size_t)CHK + tok) * 16 + h], l2 = LSE[((size_t)2 * CHK + tok) * 16 + h];
        const float mx = fmaxf(l0, fmaxf(l1, l2));
        float w0 = __expf(l0 - mx), w1 = __expf(l1 - mx), w2 = __expf(l2 - mx);
        const float inv = 1.0f / (w0 + w1 + w2); w0 *= inv; w1 *= inv; w2 *= inv;
        const uint4 a = *(const uint4*)(Hc + (size_t)tok * 1024 + c8), b = *(const uint4*)(OG + (size_t)tok * 1024 + c8), c = *(const uint4*)(OG + ((size_t)CHK + tok) * 1024 + c8);
        uint4 o;
        o.x = pack2(w0 * bflo(a.x) + w1 * bflo(b.x) + w2 * bflo(c.x), w0 * bfhi(a.x) + w1 * bfhi(b.x) + w2 * bfhi(c.x));
        o.y = pack2(w0 * bflo(a.y) + w1 * bflo(b.y) + w2 * bflo(c.y), w0 * bfhi(a.y) + w1 * bfhi(b.y) + w2 * bfhi(c.y));
        o.z = pack2(w0 * bflo(a.z) + w1 * bflo(b.z) + w2 * bflo(c.z), w0 * bfhi(a.z) + w1 * bfhi(b.z) + w2 * bfhi(c.z));
        o.w = pack2(w0 * bflo(a.w) + w1 * bflo(b.w) + w2 * bflo(c.w), w0 * bfhi(a.w) + w1 * bfhi(b.w) + w2 * bfhi(c.w));
        *(uint4*)(Hc + (size_t)tok * 1024 + c8) = o;
    }
}

constexpr int BM_VS = 576, BM_WS = 272;
__device__ void phase_b_mix(const Params& p, const bf16_t* __restrict__ Z, bf16_t* __restrict__ Gt, const float2* __restrict__ stats, const bf16_t* __restrict__ WsB, LAS unsigned char* lds) {
    const int tid = tid_opaque(), lane = tid & 63, wid = __builtin_amdgcn_readfirstlane(tid >> 6), n = lane & 31, hf = lane >> 5;
    LAS unsigned char* Vl = lds; LAS unsigned char* Wl = lds + 128 * BM_VS; LAS float* stl = (LAS float*)(lds + 128 * BM_VS + 128 * BM_WS);
    const bool rmap = gridDim.x == 256;
    for (int unit = blockIdx.x; unit < 128 * 8; unit += gridDim.x) {
        int tc = unit >> 3, g = unit & 7;
        if (rmap) { const int idx = (int)(blockIdx.x >> 3) + 32 * (unit >> 8); tc = 16 * (int)(blockIdx.x & 7) + (idx >> 3); g = idx & 7; }
        __syncthreads();
        if (tid < 128) {
            const f32x4* sp = (const f32x4*)(stats + (size_t)(tc * 128 + tid) * 8);
            const f32x4 a = sp[0], b = sp[1], c = sp[2], d = sp[3];
            const float S1 = ((a[0] + a[2]) + (b[0] + b[2])) + ((c[0] + c[2]) + (d[0] + d[2])), S2 = ((a[1] + a[3]) + (b[1] + b[3])) + ((c[1] + c[3]) + (d[1] + d[3]));
            const float mu = S1 * (1.0f / 2048.0f), var = fmaxf(S2 * (1.0f / 2048.0f) - mu * mu, 0.f);
            stl[2 * tid] = mu; stl[2 * tid + 1] = 1.0f / sqrtf(var + 1e-5f);
        }
        for (int piece = tid; piece < 2048; piece += 512) {
            const int pr = piece >> 4, c8 = (piece & 15) * 8;
            *(LAS u32x4*)(Wl + pr * BM_WS + c8 * 2) = *(const u32x4*)(WsB + (size_t)(g * 128 + pr) * 128 + c8);
        }
        __syncthreads();
        {
            const int c8 = (tid & 31) * 8, ch = g * 256 + c8;
            const float4 g0 = *(const float4*)(p.b_ln_g + ch), g1 = *(const float4*)(p.b_ln_g + ch + 4), b0 = *(const float4*)(p.b_ln_b + ch), b1 = *(const float4*)(p.b_ln_b + ch + 4);
            uint4 wv[8];
#pragma unroll
            for (int it = 0; it < 8; ++it) { const int q = (tid >> 5) + 16 * it; wv[it] = *(const uint4*)(Z + (size_t)(tc * 128 + q) * 4096 + 2048 + ch); }
#pragma unroll
            for (int it = 0; it < 8; ++it) {
                const int q = (tid >> 5) + 16 * it; const uint4 w = wv[it];
                const float2 st = make_float2(stl[2 * q], stl[2 * q + 1]);
                u32x4 o;
                o.x = pack2((bflo(w.x) - st.x) * st.y * g0.x + b0.x, (bfhi(w.x) - st.x) * st.y * g0.y + b0.y);
                o.y = pack2((bflo(w.y) - st.x) * st.y * g0.z + b0.z, (bfhi(w.y) - st.x) * st.y * g0.w + b0.w);
                o.z = pack2((bflo(w.z) - st.x) * st.y * g1.x + b1.x, (bfhi(w.z) - st.x) * st.y * g1.y + b1.y);
                o.w = pack2((bflo(w.w) - st.x) * st.y * g1.z + b1.z, (bfhi(w.w) - st.x) * st.y * g1.w + b1.w);
                *(LAS u32x4*)(Vl + q * BM_VS + c8 * 2) = o;
            }
        }
        __syncthreads();
        f32x16 acc[4];
#pragma unroll
        for (int pt = 0; pt < 4; ++pt)
#pragma unroll
            for (int i = 0; i < 16; ++i) acc[pt][i] = 0.f;
        const unsigned va = lds_off(Vl) + (unsigned)((8 * hf + ((lane & 15) >> 2)) * BM_VS + (32 * wid + 16 * ((lane >> 4) & 1) + 4 * (lane & 3)) * 2);
        const LAS unsigned char* wb = Wl + n * BM_WS + 16 * hf;
#pragma unroll 2
        for (int ks = 0; ks < 8; ++ks) {
            const bf16x8 af = tr_read2(va + (unsigned)(16 * ks * BM_VS), va + (unsigned)((16 * ks + 4) * BM_VS));
#pragma unroll
            for (int pt = 0; pt < 4; ++pt) { const bf16x8 bf = *(const LAS bf16x8*)(wb + pt * 32 * BM_WS + 32 * ks); acc[pt] = __builtin_amdgcn_mfma_f32_32x32x16_bf16(af, bf, acc[pt], 0, 0, 0); }
        }
#pragma unroll
        for (int pt = 0; pt < 4; ++pt) {
            const int pr = 32 * pt + n;
            const float bs = p.b_bs[g * 128 + pr];
            const bf16_t* up = Z + (size_t)(tc * 128 + pr) * 4096 + g * 256 + 32 * wid + 4 * hf;
            bf16_t* gp = Gt + (size_t)(tc * 128 + pr) * 2048 + g * 256 + 32 * wid + 4 * hf;
#pragma unroll
            for (int gq = 0; gq < 4; ++gq) {
                const uint2 uw = *(const uint2*)(up + 8 * gq);
                uint2 o;
                o.x = pg8::cvt_pk_bf16(bflo(uw.x) * (acc[pt][4 * gq] + bs), bfhi(uw.x) * (acc[pt][4 * gq + 1] + bs));
                o.y = pg8::cvt_pk_bf16(bflo(uw.y) * (acc[pt][4 * gq + 2] + bs), bfhi(uw.y) * (acc[pt][4 * gq + 3] + bs));
                *(uint2*)(gp + 8 * gq) = o;
            }
        }
    }
}

struct Prog { unsigned v[192]; int n; };
constexpr Prog make_prog() {
    Prog P{}; int n = 0;
    auto add = [&](int type, int layer, int chunk) { const int reps = 1 + (type == PROBE_TYPE ? PROBE_REP : 0); for (int q = 0; q < reps; ++q) P.v[n++] = (unsigned)type | ((unsigned)layer << 8) | ((unsigned)chunk << 16) | (q + 1 < reps ? (1u << 24) : 0u); };
    add(PH_PREP, 0, 0);
    if (PROBE_TYPE == 99) for (int q = 0; q < PROBE_REP; ++q) P.v[n++] = 99u;
    for (int i = 0; i < 4; ++i) {
        const int kind = i % 3;
        if (kind == 0) { add(PH_A_QKV, i, 0); add(PH_A_ATTN, i, 0); add(PH_A_WO, i, 0); }
        else if (kind == 1) { for (int c = 0; c < NCHK; ++c) { add(PH_B_IN, i, c); add(PH_B_MIX, i, c); add(PH_B_OUT, i, c); } }
        else { for (int c = 0; c < NCHK; ++c) { add(PH_C_QKV, i, c); add(PH_C_ATTN, i, c); add(PH_C_MERGE, i, c); } add(PH_C_WO, i, 0); }
        for (int c = 0; c < NCHK; ++c) { add(PH_FFN1, i, c); add(PH_FFN2, i, c); }
    }
    add(PH_FINAL, 0, 0);
    P.n = n; return P;
}
constexpr Prog h_prog = make_prog();
__device__ const Prog d_prog = make_prog();

__global__ void __launch_bounds__(512, 2) mega(Params p, int pb, int pe) {
    extern __shared__ __attribute__((aligned(16))) unsigned char shm[];
    cg::grid_group grid = cg::this_grid();
    bf16_t* const Wt = (bf16_t*)(p.ws + WS_WT);
    bf16_t* const H = (bf16_t*)(p.ws + WS_H);
    bf16_t* const Pb = (bf16_t*)(p.ws + WS_P);
    float* const ssq0 = (float*)(p.ws + WS_S + S_SSQ0);
    float* const ssq1 = (float*)(p.ws + WS_S + S_SSQ1);
    unsigned char* const S = p.ws + WS_S;
    volatile LAS unsigned* st = (volatile LAS unsigned*)((LAS unsigned char*)shm + 131072);
    unsigned* const bar = (unsigned*)(p.ws + WS_BAR);
    if (pe - pb > 1) {
        if (blockIdx.x == 0) for (int i = threadIdx.x; i < XCD_BAR_WORDS; i += 512) bar[i] = 0u;
        if (threadIdx.x < 4) st[threadIdx.x] = 0u;
    }
    XcdBarrier xb; xb.bar = bar; xb.x = 0u; xb.st = st;
    for (int ph = pb; ph < pe; ++ph) {
        if (ph == pb + 1) { grid.sync(); xb = xcd_barrier_post(bar, st); }
        else if (ph > pb + 1) { const unsigned cd = d_prog.v[ph]; const int ty = cd & 0xff, ck = (cd >> 16) & 0xff, ly = (cd >> 8) & 0xff;
            if (__builtin_amdgcn_readfirstlane((int)st[3]) == 1 && (ty == PH_FFN2 || (ty == PH_FFN1 && (ck > 0 || ly == 1 || ly == 2)) || ty == PH_B_MIX || ty == PH_B_OUT || ty == PH_B_IN ||
                 ty == PH_A_ATTN || ty == PH_A_WO || ty == PH_C_ATTN || ty == PH_C_MERGE || (ty == PH_C_QKV && ck > 0))) xcd_local_barrier(xb); else xcd_barrier(xb); }
        const unsigned code = d_prog.v[ph];
        const int type = code & 0xff, layer = (code >> 8) & 0xff, chunk = (code >> 16) & 0xff;
        pg8::Gemm g; g.A = nullptr; g.Bt = nullptr; g.M = 0; g.N = 0; g.K = 0; g.lda = 0;
        void* outp = nullptr; int ldc = 0, epi = -1;
        const size_t crow = (size_t)chunk * CHK;
        const float* rssq = nullptr; float* wssq = nullptr; float* zssq = nullptr;
        switch (type) {
            case PH_A_QKV: g.A = Pb; g.lda = 1024; g.Bt = Wt + OFF_AQKV + (size_t)(layer / 3) * 1572864; g.M = T_TOK; g.N = 1536; g.K = 1024; outp = S; ldc = 1536; epi = 0; rssq = ssq0; break;
            case PH_A_WO:  g.A = H; g.lda = 1024; g.Bt = Wt + OFF_AWO + (size_t)(layer / 3) * 1048576; g.M = T_TOK; g.N = 1024; g.K = 1024; epi = 3; wssq = ssq1; break;
            case PH_FFN1:  g.A = Pb + crow * 1024; g.lda = 1024; g.Bt = Wt + OFF_W1 + (size_t)layer * 4194304; g.M = CHK; g.N = 4096; g.K = 1024; outp = S; ldc = 4096; epi = 2; rssq = ssq1 + crow * 4; break;
            case PH_FFN2:  g.A = (const bf16_t*)S; g.lda = 4096; g.Bt = Wt + OFF_W2 + (size_t)layer * 4194304; g.M = CHK; g.N = 1024; g.K = 4096; epi = 3; wssq = ssq0; break;
            case PH_B_IN:  g.A = Pb + crow * 1024; g.lda = 1024; g.Bt = Wt + OFF_BWIN; g.M = CHK; g.N = 4096; g.K = 1024; outp = S; ldc = 4096; epi = 1; rssq = ssq0 + crow * 4; break;
            case PH_B_OUT: g.A = (const bf16_t*)(S + S_GATE); g.lda = 2048; g.Bt = Wt + OFF_BWO; g.M = CHK; g.N = 1024; g.K = 2048; epi = 3; wssq = ssq1; break;
            case PH_C_QKV: g.A = Pb + crow * 1024; g.lda = 1024; g.Bt = Wt + OFF_CQKV; g.M = CHK; g.N = 4608; g.K = 1024; outp = S; ldc = 4608; epi = 0; rssq = ssq0 + crow * 4; break;
            case PH_C_WO:  g.A = H; g.lda = 1024; g.Bt = Wt + OFF_CWO; g.M = T_TOK; g.N = 1024; g.K = 1024; epi = 3; wssq = ssq1; break;
            default: break;
        }
        if (epi >= 0) {
            if (zssq) zero_f32(zssq, T_TOK);
            const size_t xrow = (g.M == CHK) ? crow : 0;
            pg8::StaticOrder so; so.init(g.M, g.N, (int)gridDim.x, (int)blockIdx.x, type == PH_C_WO);
            if (epi == 0) { pg8::EpiBf16<0> E; E.O = (bf16_t*)outp; E.ldc = ldc; E.ssq = rssq; E.stat = nullptr; E.red2 = nullptr; E.rsl = (LAS float*)((LAS unsigned char*)shm + 131072 + 16 + 4096); pg8::gemm_phase((LAS unsigned char*)shm, g, so, E); }
            else if (epi == 1) { pg8::EpiBf16<1> E; E.O = (bf16_t*)outp; E.ldc = ldc; E.ssq = rssq; E.rsl = (LAS float*)((LAS unsigned char*)shm + 131072 + 16 + 4096); E.stat = (float2*)(S + S_STATS); E.red2 = (LAS float*)((LAS unsigned char*)shm + 131072 + 16 + 4096 + 16384); pg8::gemm_phase((LAS unsigned char*)shm, g, so, E); }
            else if (epi == 2) { pg8::EpiBf16<2> E; E.O = (bf16_t*)outp; E.ldc = ldc; E.ssq = rssq; E.stat = nullptr; E.red2 = nullptr; E.rsl = (LAS float*)((LAS unsigned char*)shm + 131072 + 16 + 4096); pg8::gemm_phase((LAS unsigned char*)shm, g, so, E); }
            else { pg8::EpiRes E; E.Cb = Pb + xrow * 1024; E.ssq = wssq + xrow * 4; E.red = (LAS float*)((LAS unsigned char*)shm + 131072 + 16); pg8::gemm_phase((LAS unsigned char*)shm, g, so, E); }
            continue;
        }
        switch (type) {
            case PH_PREP: {
                float* tile = (float*)shm;
                for (int i = 0; i < 4; ++i) convert_T(p.ffn_w1 + (size_t)i * 4194304, Wt + OFF_W1 + (size_t)i * 4194304, 1024, 4096, tile, p.norm_ffn_g + i * DM);
                for (int i = 0; i < 4; ++i) convert_T(p.ffn_w2 + (size_t)i * 4194304, Wt + OFF_W2 + (size_t)i * 4194304, 4096, 1024, tile);
                for (int j = 0; j < 2; ++j) convert_T(p.a_wqkv + (size_t)j * 1572864, Wt + OFF_AQKV + (size_t)j * 1572864, 1024, 1536, tile, p.norm_mix_g + (3 * j) * DM);
                for (int j = 0; j < 2; ++j) convert_T(p.a_wo + (size_t)j * 1048576, Wt + OFF_AWO + (size_t)j * 1048576, 1024, 1024, tile);
                convert_T(p.b_win, Wt + OFF_BWIN, 1024, 4096, tile, p.norm_mix_g + 1 * DM);
                convert_T(p.b_wo, Wt + OFF_BWO, 2048, 1024, tile);
                convert_T(p.c_wqkv, Wt + OFF_CQKV, 1024, 4608, tile, p.norm_mix_g + 2 * DM);
                convert_T(p.c_wo, Wt + OFF_CWO, 1024, 1024, tile);
                for (int i = blockIdx.x * 512 + tid_opaque(); i < 131072; i += gridDim.x * 512) Wt[OFF_BWS + i] = f2bf(p.b_ws[i]);
                phase_prep_x(p, Pb, ssq0);
            } break;
            case PH_FINAL:    phase_final(Pb, p.final_g, p.X); break;
#if NAIVE_ATTN
            case PH_A_ATTN:   phase_attn_naive((const bf16_t*)S, 1536, 1, p.rel_bias, p.a_sink + (layer / 3) * 16, H, T_TOK); break;
            case PH_C_ATTN:   phase_attn_naive((const bf16_t*)S, 4608, 3, p.rel_bias, nullptr, H + crow * 1024, CHK); break;
#else
            case PH_A_ATTN: case PH_C_ATTN: {
                const bool isC = type == PH_C_ATTN;
                phase_attn((const bf16_t*)S, isC ? 4608 : 1536, isC, p.rel_bias, isC ? nullptr : p.a_sink + (layer / 3) * 16, isC ? H + crow * 1024 : H,
                           isC ? (bf16_t*)(S + S_OG) : nullptr, isC ? (float*)(S + S_LSE) : nullptr, (LAS unsigned char*)shm);
            } break;
            case PH_C_MERGE:  phase_c_merge((const bf16_t*)(S + S_OG), (const float*)(S + S_LSE), H + crow * 1024); break;
#endif
            case PH_B_STATS:  phase_b_stats((const bf16_t*)S, (float2*)(S + S_STATS)); break;
#if NAIVE_MIX
            case PH_B_MIX:    phase_b_mix_naive(p, (bf16_t*)S, (const float2*)(S + S_STATS), (float*)shm); break;
#else
            case PH_B_MIX:    phase_b_mix(p, (const bf16_t*)S, (bf16_t*)(S + S_GATE), (const float2*)(S + S_STATS), Wt + OFF_BWS, (LAS unsigned char*)shm); break;
#endif
            default: break;
        }
    }
}

extern "C" void kernel_launch(void* const* d_in, const int* in_sizes, int n_in, void* d_out, int out_size, void* d_ws, size_t ws_size, hipStream_t stream) {
    if (n_in != 19 || out_size != T_TOK * DM || ws_size < WS_NEED) { fprintf(stderr, "kernel_launch: unexpected sizes n_in %d out %d ws %zu\n", n_in, out_size, ws_size); return; }
    Params p; memset(&p, 0, sizeof(p));
    const float** f = (const float**)&p;
    for (int i = 0; i < 19; ++i) f[i] = (const float*)d_in[i];
    p.X = (float*)d_out; p.ws = (unsigned char*)d_ws;
    static int grid = 0;
    if (!grid) {
        int dev = 0, cus = 0, per_cu = 0;
        hipGetDevice(&dev); hipDeviceGetAttribute(&cus, hipDeviceAttributeMultiprocessorCount, dev);
        hipFuncSetAttribute((const void*)mega, hipFuncAttributeMaxDynamicSharedMemorySize, LDS_BYTES);
        hipOccupancyMaxActiveBlocksPerMultiprocessor(&per_cu, (const void*)mega, 512, LDS_BYTES);
        if (per_cu < 1) { fprintf(stderr, "kernel_launch: occupancy query says %d blocks per CU\n", per_cu); per_cu = 1; }
        grid = cus * per_cu;
        (void)hipGetLastError();
    }
#if ONE_LAUNCH
    int pb = 0, pe = h_prog.n;
    void* args[] = {&p, &pb, &pe};
    hipError_t e = hipLaunchCooperativeKernel((const void*)mega, dim3(grid), dim3(512), args, LDS_BYTES, stream);
    if (e != hipSuccess) fprintf(stderr, "cooperative launch failed: %s (grid %d)\n", hipGetErrorString(e), grid);
#else
    for (int ph = 0; ph < h_prog.n; ++ph) hipLaunchKernelGGL(mega, dim3(grid), dim3(512), LDS_BYTES, stream, p, ph, ph + 1);
#endif
}
```

```cpp
#include <hip/hip_runtime.h>
#include <hip/hip_cooperative_groups.h>
#include <cstdio>
#include <cstring>
namespace cg = cooperative_groups;

#ifndef NAIVE_ATTN
#define NAIVE_ATTN 0
#endif
#ifndef NAIVE_MIX
#define NAIVE_MIX 0
#endif
#ifndef PROBE_TYPE
#define PROBE_TYPE 0
#endif
#ifndef PROBE_REP
#define PROBE_REP 0
#endif
#ifndef ONE_LAUNCH
#define ONE_LAUNCH 1
#endif

#define LAS __attribute__((address_space(3)))
typedef unsigned short bf16_t;
typedef short bf16x8 __attribute__((ext_vector_type(8)));
typedef float f32x4 __attribute__((ext_vector_type(4)));
typedef float f32x2 __attribute__((ext_vector_type(2)));
typedef unsigned u32x4 __attribute__((ext_vector_type(4)));
typedef unsigned u32x2 __attribute__((ext_vector_type(2)));

constexpr int T_TOK = 49152, DM = 1024, SEQ = 2048, CHK = 16384, NCHK = 3;
constexpr int LDS_BYTES = 131072 + 16 + 4096 + 16384 + 8192;
constexpr size_t OFF_W1 = 0, OFF_W2 = 16777216, OFF_AQKV = 33554432, OFF_AWO = 36700160, OFF_BWIN = 38797312, OFF_BWO = 42991616,
                 OFF_CQKV = 45088768, OFF_CWO = 49807360, OFF_BWS = 50855936, WT_END = 50987008;
constexpr size_t WS_WT = 0, WS_P = 104857600, WS_H = WS_P + (size_t)T_TOK * DM * 2, WS_S = WS_H + (size_t)T_TOK * DM * 2, WS_NEED = 536870912;
constexpr size_t WS_SSQ0 = 0, WS_SSQ1 = 0;
constexpr size_t S_OG = 150994944, S_LSE = S_OG + 2 * (size_t)CHK * 1024 * 2;
constexpr size_t WS_BAR = 102236160;
constexpr size_t S_SSQ0 = 224395264, S_SSQ1 = S_SSQ0 + (size_t)T_TOK * 64;
static_assert(WS_S + S_SSQ1 + (size_t)T_TOK * 64 <= WS_NEED && S_SSQ0 >= S_LSE + 3 * (size_t)CHK * 64, "ssq buffers");
constexpr size_t S_STATS = 134217728;
constexpr size_t S_GATE = 142606336;

enum { PH_PREP = 1, PH_A_QKV, PH_A_ATTN, PH_A_WO, PH_NORM_FFN, PH_FFN1, PH_FFN2, PH_NORM_MIX, PH_B_IN, PH_B_STATS, PH_B_MIX, PH_B_OUT, PH_C_QKV, PH_C_ATTN, PH_C_WO, PH_FINAL, PH_C_MERGE };
static_assert(WS_S + S_LSE + 3 * (size_t)CHK * 16 * 4 <= WS_NEED, "workspace");

struct Params {
    const float* x_prompt; const float* x_sample; const float* rel_bias; const float* norm_mix_g; const float* norm_ffn_g; const float* final_g;
    const float* ffn_w1; const float* ffn_w2; const float* a_wqkv; const float* a_sink; const float* a_wo;
    const float* b_win; const float* b_ln_g; const float* b_ln_b; const float* b_ws; const float* b_bs; const float* b_wo;
    const float* c_wqkv; const float* c_wo;
    float* X; unsigned char* ws;
};

__device__ __forceinline__ bf16_t f2bf(float f) { unsigned u = __float_as_uint(f); u += 0x7FFFu + ((u >> 16) & 1u); return (bf16_t)(u >> 16); }
__device__ __forceinline__ float bf2f(bf16_t b) { return __uint_as_float(((unsigned)b) << 16); }
__device__ __forceinline__ float bflo(unsigned w) { return __uint_as_float(w << 16); }
__device__ __forceinline__ float bfhi(unsigned w) { return __uint_as_float(w & 0xffff0000u); }
__device__ __forceinline__ unsigned pack2(float lo, float hi) { return (unsigned)f2bf(lo) | ((unsigned)f2bf(hi) << 16); }
__device__ __forceinline__ float wave_sum(float v) { for (int o = 32; o > 0; o >>= 1) v += __shfl_xor(v, o, 64); return v; }
__device__ __forceinline__ float wave_max(float v) { for (int o = 32; o > 0; o >>= 1) v = fmaxf(v, __shfl_xor(v, o, 64)); return v; }
__device__ __forceinline__ int tid_opaque() { int t = threadIdx.x; asm volatile("" : "+v"(t)); return t; }
__device__ __forceinline__ float rdlane(float v, int l) { return __int_as_float(__builtin_amdgcn_readlane(__float_as_int(v), l)); }


#define XB_TMO      128
#define XB_XCNT(j)  (256  + 64 * (j))
#define XB_XSUB(j)  (1280 + 64 * (j))
#define XB_XGEN(j)  (2304 + 64 * (j))
#define XB_TOP      3328
#define XB_TOPGEN   3392
#define XB_LSUB(j)  (3456 + 64 * (j))
#define XB_LGEN(j)  (4480 + 64 * (j))
#define XCD_BAR_WORDS 5504
#define XB_SPIN_CAP (1u << 22)
__device__ __forceinline__ unsigned xb_ld(unsigned* p)              { return __hip_atomic_load(p, __ATOMIC_RELAXED, __HIP_MEMORY_SCOPE_AGENT); }
__device__ __forceinline__ unsigned xb_add(unsigned* p, unsigned v) { return __hip_atomic_fetch_add(p, v, __ATOMIC_RELAXED, __HIP_MEMORY_SCOPE_AGENT); }
__device__ __forceinline__ unsigned xb_xcc_id() { return (unsigned)__builtin_amdgcn_s_getreg((3 << 11) | 20) & 0xFu; }
#define XB_SPIN(cond, bar) do { unsigned _sp = 0; while (cond) { __builtin_amdgcn_s_sleep(1); \
    if ((++_sp & 255u) == 0u) { if (xb_ld(&(bar)[XB_TMO])) break; if (_sp > XB_SPIN_CAP) { atomicAdd(&(bar)[XB_TMO], 1u); break; } } } } while (0)
struct XcdBarrier { unsigned* bar; unsigned x; volatile LAS unsigned* st; };
__device__ __forceinline__ XcdBarrier xcd_barrier_post(unsigned* bar, volatile LAS unsigned* st) {
    XcdBarrier b; b.bar = bar; b.x = xb_xcc_id(); b.st = st;
    if (threadIdx.x == 0) { const unsigned rho = blockIdx.x & 7u; (void)xb_add(&bar[XB_XCNT(b.x)], 1u | (rho << 9) | ((rho * rho) << 20)); }
    return b;
}
__device__ __forceinline__ void xcd_barrier_complete(unsigned* bar, unsigned x, unsigned& nloc, unsigned& nx, bool& rr) {
    const unsigned G = gridDim.x * gridDim.y * gridDim.z;
    unsigned sum, cnt, mine, mism, even, sp = 0u;
    for (;;) {
        sum = 0u; cnt = 0u; mine = 0u; mism = 0u; even = 1u;
#pragma unroll
        for (unsigned j = 0; j < 16; ++j) { const unsigned w = xb_ld(&bar[XB_XCNT(j)]); const unsigned c = w & 0x1ffu, sr = (w >> 9) & 0x7ffu, sq = w >> 20; sum += c; cnt += (c > 0u) ? 1u : 0u; mine = (j == x) ? c : mine;
            mism += (c * sq != sr * sr) ? 1u : 0u;
            even &= (j < 8u ? c == (G >> 3) : w == 0u) ? 1u : 0u; }
        if (sum == G) break;
        __builtin_amdgcn_s_sleep(1);
        if ((++sp & 255u) == 0u) { if (xb_ld(&bar[XB_TMO])) break; if (sp > XB_SPIN_CAP) { atomicAdd(&bar[XB_TMO], 1u); break; } }
    }
    nloc = mine > 0u ? mine : 1u; nx = cnt > 0u ? cnt : 1u;
    rr = (sum == G) && (mism == 0u) && (even != 0u) && (G == 256u);
}
__device__ __forceinline__ void xcd_barrier(const XcdBarrier& b) {
    asm volatile("s_waitcnt vmcnt(0)" ::: "memory");
    __syncthreads();
    if (threadIdx.x == 0) {
        unsigned* bar = b.bar;
        __builtin_amdgcn_s_waitcnt(0);
        unsigned nloc = b.st[0], nx = b.st[1];
        if (nloc == 0u) { bool rr = false; xcd_barrier_complete(bar, b.x, nloc, nx, rr); b.st[0] = nloc; b.st[1] = nx; b.st[3] = rr ? 1u : 0u; }
        const unsigned old = xb_add(&bar[XB_XSUB(b.x)], 1u);
        const unsigned gen = old / nloc;
        if (old + 1u == (gen + 1u) * nloc) {
            __builtin_amdgcn_fence(__ATOMIC_RELEASE, "agent");
            asm volatile("s_waitcnt vmcnt(0)" ::: "memory");
            const unsigned og = xb_add(&bar[XB_TOP], 1u);
            const unsigned tg = og / nx;
            if (og + 1u == (tg + 1u) * nx) xb_add(&bar[XB_TOPGEN], 1u);
            else XB_SPIN(xb_ld(&bar[XB_TOPGEN]) == tg, bar);
            __builtin_amdgcn_fence(__ATOMIC_ACQUIRE, "agent");
            xb_add(&bar[XB_XGEN(b.x)], 1u);
            asm volatile("s_waitcnt vmcnt(0)" ::: "memory");
        } else {
            XB_SPIN(xb_ld(&bar[XB_XGEN(b.x)]) == gen, bar);
            __builtin_amdgcn_fence(__ATOMIC_ACQUIRE, "agent");
            asm volatile("s_waitcnt vmcnt(0)" ::: "memory");
        }
    }
    __syncthreads();
}

__device__ __forceinline__ void xcd_local_barrier(const XcdBarrier& b) {
    asm volatile("s_waitcnt vmcnt(0)" ::: "memory");
    __syncthreads();
    if (threadIdx.x == 0) {
        unsigned* bar = b.bar;
        __builtin_amdgcn_s_waitcnt(0);
        const unsigned nloc = b.st[0];
        const unsigned old = xb_add(&bar[XB_LSUB(b.x)], 1u);
        const unsigned gen = old / nloc;
        if (old + 1u == (gen + 1u) * nloc) xb_add(&bar[XB_LGEN(b.x)], 1u);
        else XB_SPIN(xb_ld(&bar[XB_LGEN(b.x)]) == gen, bar);
        __builtin_amdgcn_fence(__ATOMIC_ACQUIRE, "agent");
        asm volatile("s_waitcnt vmcnt(0)" ::: "memory");
    }
    __syncthreads();
}

namespace pg8 {
constexpr int BM = 256, BK = 64, HALF = 128, HTB = HALF * BK * 2, STAGE_BYTES = 8 * HTB, NXCD = 8, WGM = 4;
__host__ __device__ __forceinline__ int lds_byte(int r, int c) { const int st = (r >> 4) * 2 + (c >> 5), rr = r & 15, cc = c & 31, ob = rr * 64 + cc * 2; return st * 1024 + (ob ^ (((ob >> 9) & 1) << 5)); }
__host__ __device__ __forceinline__ void stage_rc(int b, int& R, int& C) { const int st = b / 1024, sb = b % 1024, swz = sb ^ (((sb >> 9) & 1) << 5); R = (st >> 1) * 16 + swz / 64; C = (st & 1) * 32 + (swz % 64) / 2; }
__host__ __device__ __forceinline__ int perm32(int rho) { const int n = rho >> 4, i = rho & 15; return 8 * (i >> 2) + 4 * n + (i & 3); }
struct Unit { int pm, pn; };
struct Gemm { const bf16_t* A; const bf16_t* Bt; int M, N, K, lda; };
struct StaticOrder {
    int nM, nN, nwg, G, c; bool permT;
    __device__ void init(int M, int N, int G_, int c_, bool permT_ = false) { nM = M / BM; nN = N / BM; nwg = nM * nN; G = G_; c = c_; permT = permT_ && nM == 192 && nN == 4 && G_ == 256; }
    __device__ bool next(int i, Unit& u) const {
        const long L = (long)i * G + c; if (L >= nwg) return false;
        int wgid = (int)L; { const int q = nwg / NXCD, r = nwg % NXCD, xcd = wgid % NXCD, off = wgid / NXCD; wgid = (xcd < r ? xcd * (q + 1) : r * (q + 1) + (xcd - r) * q) + off; }
        const int nig = WGM * nN, gid = wgid / nig, fm = gid * WGM, gsz = (nM - fm) < WGM ? (nM - fm) : WGM;
        u.pm = fm + ((wgid % nig) % gsz); u.pn = (wgid % nig) / gsz;
        if (permT) { const int x = u.pm / 24, j = u.pm - 24 * x; u.pm = 64 * (j >> 3) + 8 * x + (j & 7); }
        return true;
    }
};
__device__ __forceinline__ unsigned cvt_pk_bf16(float lo, float hi) { unsigned r; asm volatile("v_cvt_pk_bf16_f32 %0, %1, %2" : "=v"(r) : "v"(lo), "v"(hi)); return r; }
__device__ __forceinline__ f32x2 gelu_pk(f32x2 v) {
    const f32x2 av = __builtin_elementwise_abs(v), d = av * 0.2316418882f + 1.0f;
    f32x2 t; t.x = __builtin_amdgcn_rcpf(d.x); t.y = __builtin_amdgcn_rcpf(d.y);
    f32x2 q = t * 0.5307027145f + (-0.7265760135f); q = q * t + 0.7107068705f; q = q * t + (-0.142248368f); q = q * t + 0.127414796f; q = q * t;
    const f32x2 s = (v * v) * (-0.72134752044f);
    f32x2 e; e.x = __builtin_amdgcn_exp2f(s.x); e.y = __builtin_amdgcn_exp2f(s.y);
    const f32x2 m = v * (q * e), r = v - m;
    f32x2 o; o.x = v.x < 0.f ? m.x : r.x; o.y = v.y < 0.f ? m.y : r.y; return o;
}
struct EpiRes {
    static constexpr bool PERM = true;
    bf16_t* Cb; float* ssq; LAS float* red;
    __device__ __forceinline__ void init(f32x4 (&acc)[2][2][4][2], const Unit& u, int wr, int wc, int fr, int fq) const {
        const int row0 = u.pm * BM + wr * 64 + fr, col0 = u.pn * BM + wc * 32 + 8 * fq;
#pragma unroll
        for (int ai = 0; ai < 2; ++ai)
#pragma unroll
            for (int m = 0; m < 4; ++m) { const bf16_t* rowp = Cb + (size_t)(row0 + ai * HALF + m * 16) * DM + col0;
#pragma unroll
                for (int bj = 0; bj < 2; ++bj) { const u32x4 w = *(const u32x4*)(rowp + bj * HALF);
                    acc[ai][bj][m][0] = (f32x4){bflo(w.x), bfhi(w.x), bflo(w.y), bfhi(w.y)}; acc[ai][bj][m][1] = (f32x4){bflo(w.z), bfhi(w.z), bflo(w.w), bfhi(w.w)}; } }
    }
    __device__ __forceinline__ void operator()(const f32x4 (&acc)[2][2][4][2], const Unit& u, int wr, int wc, int fr, int fq) const {
        const int row0 = u.pm * BM + wr * 64 + fr, col0 = u.pn * BM + wc * 32 + 8 * fq;
#pragma unroll
        for (int ai = 0; ai < 2; ++ai)
#pragma unroll
            for (int m = 0; m < 4; ++m) { const int row = row0 + ai * HALF + m * 16; bf16_t* rowb = Cb + (size_t)row * DM + col0; float ss = 0.f;
#pragma unroll
                for (int bj = 0; bj < 2; ++bj) { const f32x4 v0 = acc[ai][bj][m][0], v1 = acc[ai][bj][m][1];
                    u32x4 w; w.x = cvt_pk_bf16(v0[0], v0[1]); w.y = cvt_pk_bf16(v0[2], v0[3]); w.z = cvt_pk_bf16(v1[0], v1[1]); w.w = cvt_pk_bf16(v1[2], v1[3]);
                    *(u32x4*)(rowb + bj * HALF) = w;
                    ss += v0[0] * v0[0] + v0[1] * v0[1] + v0[2] * v0[2] + v0[3] * v0[3] + v1[0] * v1[0] + v1[1] * v1[1] + v1[2] * v1[2] + v1[3] * v1[3]; }
                ss += __shfl_xor(ss, 16, 64); ss += __shfl_xor(ss, 32, 64);
                if (fq == 0) red[(wr * 64 + fr + ai * HALF + m * 16) * 4 + wc] = ss; }
        asm volatile("s_waitcnt lgkmcnt(0)" ::: "memory"); __builtin_amdgcn_s_barrier(); asm volatile("" ::: "memory");
        if (wc == 0 && fq == 0) {
#pragma unroll
            for (int ai = 0; ai < 2; ++ai)
#pragma unroll
                for (int m = 0; m < 4; ++m) { const int rl = wr * 64 + fr + ai * HALF + m * 16; const f32x4 v = *(const LAS f32x4*)(red + rl * 4);
                    ssq[(size_t)(u.pm * BM + rl) * 4 + u.pn] = (v[0] + v[1]) + (v[2] + v[3]); }
        }
    }
};
template <int ACT  > struct EpiBf16 {
    static constexpr bool PERM = true;
    bf16_t* O; int ldc; const float* ssq; LAS float* rsl; float2* stat; LAS float* red2;
    __device__ __forceinline__ void init(f32x4 (&acc)[2][2][4][2], const Unit& u, int wr, int wc, int fr, int fq) const {
        {
            const float* src = ssq + (size_t)(u.pm * BM + wr * 64 + fq * 16 + fr) * 4;
            LAS unsigned char* dst = (LAS unsigned char*)rsl + (wr * 4 + wc) * 2048;
            __builtin_amdgcn_global_load_lds((const unsigned*)src, (LAS unsigned*)dst, 16, 0, 0);
            __builtin_amdgcn_global_load_lds((const unsigned*)(src + HALF * 4), (LAS unsigned*)(dst + 1024), 16, 0, 0);
        }
#pragma unroll
        for (int a = 0; a < 2; ++a)
#pragma unroll
            for (int b = 0; b < 2; ++b)
#pragma unroll
                for (int m = 0; m < 4; ++m)
#pragma unroll
                    for (int n = 0; n < 2; ++n) acc[a][b][m][n] = (f32x4){0.f, 0.f, 0.f, 0.f};
    }
    __device__ __forceinline__ void operator()(const f32x4 (&acc)[2][2][4][2], const Unit& u, int wr, int wc, int fr, int fq) const {
        const int row0 = u.pm * BM + wr * 64 + fr, col0 = u.pn * BM + wc * 32 + 8 * fq;
        const bool dost = (ACT == 1) && u.pn >= 8;
#pragma unroll
        for (int ai = 0; ai < 2; ++ai)
#pragma unroll
            for (int m = 0; m < 4; ++m) { const int row = row0 + ai * HALF + m * 16; bf16_t* rowp = O + (size_t)row * ldc + col0;
                const f32x4 s4 = *(const LAS f32x4*)((const LAS unsigned char*)rsl + (wr * 4 + wc) * 2048 + ai * 1024 + (m * 16 + fr) * 16);
                const float rs = __builtin_amdgcn_rsqf(((s4[0] + s4[1]) + (s4[2] + s4[3])) * (1.0f / 1024.0f) + 1e-6f);
                float s1 = 0.f, s2 = 0.f;
#pragma unroll
                for (int bj = 0; bj < 2; ++bj) { f32x4 v0, v1;
                    if (ACT == 2) { const f32x4 a0 = acc[ai][bj][m][0], a1 = acc[ai][bj][m][1], z4 = (f32x4){0.f, 0.f, 0.f, 0.f}; const float rs2 = rs * rs;
                        v0 = (a0 * __builtin_elementwise_max(a0, z4)) * rs2; v1 = (a1 * __builtin_elementwise_max(a1, z4)) * rs2; }
                    else { v0 = acc[ai][bj][m][0] * rs; v1 = acc[ai][bj][m][1] * rs; }
                    if (ACT == 1) { f32x2 a = gelu_pk((f32x2){v0[0], v0[1]}), b = gelu_pk((f32x2){v0[2], v0[3]}), c = gelu_pk((f32x2){v1[0], v1[1]}), d = gelu_pk((f32x2){v1[2], v1[3]});
                        v0 = (f32x4){a.x, a.y, b.x, b.y}; v1 = (f32x4){c.x, c.y, d.x, d.y};
                        s1 += ((v0[0] + v0[1]) + (v0[2] + v0[3])) + ((v1[0] + v1[1]) + (v1[2] + v1[3]));
                        s2 += ((v0[0] * v0[0] + v0[1] * v0[1]) + (v0[2] * v0[2] + v0[3] * v0[3])) + ((v1[0] * v1[0] + v1[1] * v1[1]) + (v1[2] * v1[2] + v1[3] * v1[3])); }
                    u32x4 w; w.x = cvt_pk_bf16(v0[0], v0[1]); w.y = cvt_pk_bf16(v0[2], v0[3]); w.z = cvt_pk_bf16(v1[0], v1[1]); w.w = cvt_pk_bf16(v1[2], v1[3]);
                    *(u32x4*)(rowp + bj * HALF) = w; }
                if (ACT == 1) { if (dost) { s1 += __shfl_xor(s1, 16, 64); s2 += __shfl_xor(s2, 16, 64);
                    { const u32x2 a = __builtin_amdgcn_permlane32_swap(__float_as_uint(s1), __float_as_uint(s1), false, false), b = __builtin_amdgcn_permlane32_swap(__float_as_uint(s2), __float_as_uint(s2), false, false);
                      s1 = __uint_as_float(a[0]) + __uint_as_float(a[1]); s2 = __uint_as_float(b[0]) + __uint_as_float(b[1]); }
                    if (fq == 0) { LAS float* rp = red2 + ((wr * 64 + fr + ai * HALF + m * 16) * 4 + wc) * 2; rp[0] = s1; rp[1] = s2; } } } }
        if (ACT == 1) { if (dost) {
            asm volatile("s_waitcnt lgkmcnt(0)" ::: "memory"); __builtin_amdgcn_s_barrier(); asm volatile("" ::: "memory");
            if (wc == 0 && fq == 0) {
#pragma unroll
                for (int ai = 0; ai < 2; ++ai)
#pragma unroll
                    for (int m = 0; m < 4; ++m) { const int rl = wr * 64 + fr + ai * HALF + m * 16; const f32x4 a = *(const LAS f32x4*)(red2 + rl * 8), b = *(const LAS f32x4*)(red2 + rl * 8 + 4);
                        stat[(size_t)(u.pm * BM + rl) * 8 + (u.pn - 8)] = make_float2((a[0] + a[2]) + (b[0] + b[2]), (a[1] + a[3]) + (b[1] + b[3])); }
            } } }
    }
};

template <class Epi>
__device__ __forceinline__ void gemm_phase(LAS unsigned char* lds, const Gemm g, const StaticOrder& S, const Epi& E) {
    const int tid = tid_opaque(), wid = __builtin_amdgcn_readfirstlane(tid >> 6), lane = tid & 63, wr = wid >> 2, wc = wid & 3, fr = lane & 15, fq = lane >> 4;
    const int K = g.K, nt = K / BK, lda = g.lda;
    unsigned voffA[2], voffB[2];
#pragma unroll
    for (int i = 0; i < 2; ++i) { int R, C; stage_rc(tid * 16 + i * 8192, R, C); const int Rb = Epi::PERM ? ((R & ~31) + perm32(R & 31)) : R;
        voffA[i] = (unsigned)(R * lda + C) * 2u; voffB[i] = (unsigned)(Rb * K + C) * 2u; }
    const size_t kstep = (size_t)(BK * 2);
    const size_t hstepA = (size_t)HALF * lda * 2, hstepB = (size_t)HALF * K * 2;
    const size_t tstepA = 2 * hstepA, tstepB = 2 * hstepB;
    const unsigned ldsw = (unsigned)wid * 1024u;
    const int aoff = lds_byte(wr * 64 + fr, fq * 8), boff = lds_byte(wc * 32 + fr, fq * 8);
#define PG8_SA(b, h) (((b) * 2 + (h)) * HTB)
#define PG8_SB(b, h) ((4 + (b) * 2 + (h)) * HTB)
#define PG8_STAGE(bufoff, gbase, voff) do { _Pragma("unroll") for (int _i = 0; _i < 2; ++_i) \
        __builtin_amdgcn_global_load_lds((const unsigned*)((const char*)(gbase) + (voff)[_i]), (LAS unsigned*)(lds + (bufoff) + ldsw + _i * 8192), 16, 0, 0); } while (0)
#define PG8_LDA(dst, b, h) do { _Pragma("unroll") for (int m = 0; m < 4; ++m) _Pragma("unroll") for (int k = 0; k < 2; ++k) dst[m][k] = *(const LAS bf16x8*)(lds + PG8_SA(b, h) + aoff + m * 2048 + k * 1024); } while (0)
#define PG8_LDB(dst, b, h) do { _Pragma("unroll") for (int n = 0; n < 2; ++n) _Pragma("unroll") for (int k = 0; k < 2; ++k) dst[n][k] = *(const LAS bf16x8*)(lds + PG8_SB(b, h) + boff + n * 2048 + k * 1024); } while (0)
#define PG8_MMA(ai, bj, At, Bt) do { __builtin_amdgcn_s_setprio(1); _Pragma("unroll") for (int m = 0; m < 4; ++m) _Pragma("unroll") for (int n = 0; n < 2; ++n) _Pragma("unroll") for (int k = 0; k < 2; ++k) \
        acc[ai][bj][m][n] = __builtin_amdgcn_mfma_f32_16x16x32_bf16(Bt[n][k], At[m][k], acc[ai][bj][m][n], 0, 0, 0); __builtin_amdgcn_s_setprio(0); } while (0)
#define PG8_WAIT_V(n) asm volatile("s_waitcnt vmcnt(" #n ")" ::: "memory")
#define PG8_WAIT_L(n) asm volatile("s_waitcnt lgkmcnt(" #n ")" ::: "memory")
#define PG8_BAR __builtin_amdgcn_s_barrier()
#define PG8_SCHED __builtin_amdgcn_sched_barrier(0)
    Unit cur, nxt; int ui = 0;
    if (!S.next(0, cur)) return;
    f32x4 acc[2][2][4][2];
    E.init(acc, cur, wr, wc, fr, fq);
    bf16x8 At[4][2], B0[2][2], B1[2][2];
    const char* cA = (const char*)g.A + (size_t)cur.pm * tstepA; const char* cB = (const char*)g.Bt + (size_t)cur.pn * tstepB;
    PG8_STAGE(PG8_SB(0, 0), cB, voffB); PG8_STAGE(PG8_SB(0, 1), cB + hstepB, voffB); PG8_STAGE(PG8_SA(0, 0), cA, voffA); PG8_STAGE(PG8_SA(0, 1), cA + hstepA, voffA);
    if (wr == 1) PG8_BAR;
    PG8_WAIT_V(2); PG8_BAR;
    PG8_STAGE(PG8_SB(1, 0), cB + kstep, voffB); PG8_STAGE(PG8_SA(1, 0), cA + kstep, voffA); PG8_STAGE(PG8_SB(1, 1), cB + hstepB + kstep, voffB);
    PG8_WAIT_V(6); PG8_BAR;
    for (;;) {
        const bool has_next = S.next(ui + 1, nxt);
        const char* nA = has_next ? (const char*)g.A + (size_t)nxt.pm * tstepA : cA; const char* nB = has_next ? (const char*)g.Bt + (size_t)nxt.pn * tstepB : cB;
        for (int t = 0; t < nt; t += 2) {
            const bool last = (t == nt - 2);
            const char* a1 = cA + (size_t)(t + 1) * kstep;
            const char* a2 = last ? nA : cA + (size_t)(t + 2) * kstep; const char* b2 = last ? nB : cB + (size_t)(t + 2) * kstep;
            const char* a3 = a2 + kstep; const char* b3 = b2 + kstep;
            PG8_LDB(B0, 0, 0); PG8_LDB(B1, 0, 1); PG8_SCHED; PG8_LDA(At, 0, 0); PG8_STAGE(PG8_SA(1, 1), a1 + hstepA, voffA);
            PG8_WAIT_V(8); PG8_WAIT_L(0); PG8_BAR; PG8_MMA(0, 0, At, B0); PG8_MMA(0, 1, At, B1); PG8_BAR; PG8_SCHED;
            PG8_LDA(At, 0, 1); PG8_STAGE(PG8_SB(0, 0), b2, voffB); PG8_STAGE(PG8_SB(0, 1), b2 + hstepB, voffB); PG8_STAGE(PG8_SA(0, 0), a2, voffA);
            PG8_WAIT_V(8); PG8_WAIT_L(0); PG8_BAR; PG8_MMA(1, 0, At, B0); PG8_MMA(1, 1, At, B1); PG8_BAR; PG8_SCHED;
            PG8_LDB(B0, 1, 0); PG8_LDB(B1, 1, 1); PG8_SCHED; PG8_LDA(At, 1, 0); PG8_STAGE(PG8_SA(0, 1), a2 + hstepA, voffA);
            PG8_WAIT_V(8); PG8_WAIT_L(0); PG8_BAR; PG8_MMA(0, 0, At, B0); PG8_MMA(0, 1, At, B1); PG8_BAR; PG8_SCHED;
            PG8_LDA(At, 1, 1); PG8_STAGE(PG8_SB(1, 0), b3, voffB); PG8_STAGE(PG8_SB(1, 1), b3 + hstepB, voffB); PG8_STAGE(PG8_SA(1, 0), a3, voffA);
            PG8_WAIT_V(8); PG8_WAIT_L(0); PG8_BAR; PG8_MMA(1, 0, At, B0); PG8_MMA(1, 1, At, B1); PG8_BAR; PG8_SCHED;
        }
        if (wr == 0) PG8_BAR;
        E(acc, cur, wr, wc, fr, fq);
        if (!has_next) break;
        E.init(acc, nxt, wr, wc, fr, fq);
        cur = nxt; cA = nA; cB = nB; ++ui;
        if (wr == 1) PG8_BAR;
    }
    PG8_WAIT_V(0);
    PG8_BAR;
#undef PG8_SA
#undef PG8_SB
#undef PG8_STAGE
#undef PG8_LDA
#undef PG8_LDB
#undef PG8_MMA
#undef PG8_WAIT_V
#undef PG8_WAIT_L
#undef PG8_BAR
#undef PG8_SCHED
}
}

__device__ __forceinline__ int rel_bucket(int rel) {
    const int n = rel < 0 ? -rel : rel;
    const int b = n < 8 ? n : (8 + (n >= 15) + (n >= 27) + (n >= 50) + (n >= 91) + (n >= 166) + (n >= 305) + (n >= 559));
    return (rel > 0 ? 16 : 0) + b;
}

__device__ void convert_T(const float* __restrict__ src, bf16_t* __restrict__ dst, int K, int N, float* tile, const float* __restrict__ gk = nullptr) {
    const int tn = N / 64, nt = (K / 64) * tn, tid = tid_opaque();
    for (int t = blockIdx.x; t < nt; t += gridDim.x) {
        const int k0 = (t / tn) * 64, n0 = (t % tn) * 64;
        for (int idx = tid; idx < 1024; idx += 512) {
            const int kk = idx >> 4, n4 = (idx & 15) * 4;
            const float4 v = *(const float4*)(src + (size_t)(k0 + kk) * N + n0 + n4);
            const float gg = gk ? gk[k0 + kk] : 1.0f;
            float* tp = tile + kk * 65 + n4; tp[0] = v.x * gg; tp[1] = v.y * gg; tp[2] = v.z * gg; tp[3] = v.w * gg;
        }
        __syncthreads();
        {
            const int nn = tid >> 3, kk0 = (tid & 7) * 8;
            const float* tp = tile + kk0 * 65 + nn;
            uint4 w; w.x = pack2(tp[0], tp[65]); w.y = pack2(tp[130], tp[195]); w.z = pack2(tp[260], tp[325]); w.w = pack2(tp[390], tp[455]);
            *(uint4*)(dst + (size_t)(n0 + nn) * K + k0 + kk0) = w;
        }
        __syncthreads();
    }
}

__device__ void phase_norm(const Params& p, const float* __restrict__ src  , const float* __restrict__ g, bf16_t* __restrict__ H, float* __restrict__ Xc, float* __restrict__ Fout) {
    const int tid = tid_opaque(), lane = tid & 63, gw = blockIdx.x * 8 + (tid >> 6), nw = gridDim.x * 8;
    float4 gv[4];
#pragma unroll
    for (int k = 0; k < 4; ++k) gv[k] = *(const float4*)(g + lane * 4 + 256 * k);
    for (int r = gw; r < T_TOK; r += nw) {
        const float* row = src ? src + (size_t)r * DM : (r < 32768 ? p.x_prompt + (size_t)r * DM : p.x_sample + (size_t)(r - 32768) * DM);
        float4 v[4]; float ss = 0.f;
#pragma unroll
        for (int k = 0; k < 4; ++k) { v[k] = *(const float4*)(row + lane * 4 + 256 * k); ss += v[k].x * v[k].x + v[k].y * v[k].y + v[k].z * v[k].z + v[k].w * v[k].w; }
        ss = wave_sum(ss);
        const float rstd = 1.0f / sqrtf(ss * (1.0f / 1024.0f) + 1e-6f);
#pragma unroll
        for (int k = 0; k < 4; ++k) {
            const float a = v[k].x * rstd * gv[k].x, b = v[k].y * rstd * gv[k].y, c = v[k].z * rstd * gv[k].z, d = v[k].w * rstd * gv[k].w;
            if (H) { uint2 w; w.x = pack2(a, b); w.y = pack2(c, d); *(uint2*)(H + (size_t)r * DM + lane * 4 + 256 * k) = w; }
            if (Xc) *(float4*)(Xc + (size_t)r * DM + lane * 4 + 256 * k) = v[k];
            if (Fout) *(float4*)(Fout + (size_t)r * DM + lane * 4 + 256 * k) = make_float4(a, b, c, d);
        }
    }
}


__device__ void phase_prep_x(const Params& p, bf16_t* __restrict__ Xb, float* __restrict__ ssq) {
    const int tid = tid_opaque(), lane = tid & 63, gw = blockIdx.x * 8 + (tid >> 6), nw = gridDim.x * 8;
    for (int r = gw; r < T_TOK; r += nw) {
        const float* row = r < 32768 ? p.x_prompt + (size_t)r * DM : p.x_sample + (size_t)(r - 32768) * DM;
        float ss = 0.f;
#pragma unroll
        for (int k = 0; k < 4; ++k) { const float4 v = *(const float4*)(row + lane * 4 + 256 * k); ss += v.x * v.x + v.y * v.y + v.z * v.z + v.w * v.w;
            uint2 w; w.x = pack2(v.x, v.y); w.y = pack2(v.z, v.w); *(uint2*)(Xb + (size_t)r * DM + lane * 4 + 256 * k) = w; }
        ss = wave_sum(ss);
        if (lane < 4) ssq[(size_t)r * 4 + lane] = lane == 0 ? ss : 0.f;
    }
}

__device__ void phase_final(const bf16_t* __restrict__ Xb, const float* __restrict__ g, float* __restrict__ out) {
    const int tid = tid_opaque(), lane = tid & 63, gw = blockIdx.x * 8 + (tid >> 6), nw = gridDim.x * 8;
    for (int r = gw; r < T_TOK; r += nw) {
        float x[16]; float ss = 0.f;
#pragma unroll
        for (int k = 0; k < 2; ++k) { const uint4 w = *(const uint4*)(Xb + (size_t)r * DM + lane * 8 + 512 * k);
            x[8 * k + 0] = bflo(w.x); x[8 * k + 1] = bfhi(w.x); x[8 * k + 2] = bflo(w.y); x[8 * k + 3] = bfhi(w.y);
            x[8 * k + 4] = bflo(w.z); x[8 * k + 5] = bfhi(w.z); x[8 * k + 6] = bflo(w.w); x[8 * k + 7] = bfhi(w.w); }
#pragma unroll
        for (int k = 0; k < 16; ++k) ss += x[k] * x[k];
        ss = wave_sum(ss);
        const float rstd = 1.0f / sqrtf(ss * (1.0f / 1024.0f) + 1e-6f);
#pragma unroll
        for (int k = 0; k < 2; ++k) {
            const float4 g0 = *(const float4*)(g + lane * 8 + 512 * k), g1 = *(const float4*)(g + lane * 8 + 512 * k + 4);
            float* op = out + (size_t)r * DM + lane * 8 + 512 * k;
            *(float4*)op = make_float4(x[8 * k] * rstd * g0.x, x[8 * k + 1] * rstd * g0.y, x[8 * k + 2] * rstd * g0.z, x[8 * k + 3] * rstd * g0.w);
            *(float4*)(op + 4) = make_float4(x[8 * k + 4] * rstd * g1.x, x[8 * k + 5] * rstd * g1.y, x[8 * k + 6] * rstd * g1.z, x[8 * k + 7] * rstd * g1.w);
        }
    }
}
__device__ __forceinline__ void zero_f32(float* p, int n) { for (int i = blockIdx.x * 512 + tid_opaque(); i < n; i += gridDim.x * 512) p[i] = 0.f; }

__device__ void phase_attn_naive(const bf16_t* __restrict__ qkv, int ld, int ngroups, const float* __restrict__ rel_bias, const float* __restrict__ sink, bf16_t* __restrict__ out, int ntok) {
    const int tid = tid_opaque(), lane = tid & 63, gw = blockIdx.x * 8 + (tid >> 6), nw = gridDim.x * 8;
    for (int item = gw; item < ntok * 16; item += nw) {
        const int tok = item >> 4, h = item & 15, g = h >> 2;
        const int i = tok & (SEQ - 1), seqbase = tok - i;
        float m = sink ? sink[h] : -INFINITY, l = sink ? 1.f : 0.f, o = 0.f;
        for (int gi = 0; gi < ngroups; ++gi) {
            const int dil = ngroups == 1 ? 1 : (gi == 0 ? 1 : (gi == 1 ? 4 : 16));
            const int R = ngroups == 1 ? 128 : 64;
            const int L = SEQ / dil, t = i / dil, r = i % dil;
            const bf16_t* base = qkv + (size_t)gi * 1536;
            const float qv = bf2f(base[(size_t)tok * ld + h * 64 + lane]) * 0.125f;
            const int nb = (2 * R + 1 + 63) / 64;
            for (int b = 0; b < nb; ++b) {
                const int tp = t - R + 64 * b + lane;
                const bool valid = tp >= 0 && tp < L && tp <= t + R;
                const int tpc = min(max(tp, 0), L - 1);
                const uint4* kp = (const uint4*)(base + (size_t)(seqbase + tpc * dil + r) * ld + 1024 + g * 64);
                float s = 0.f;
#pragma unroll
                for (int c = 0; c < 8; ++c) {
                    const uint4 kv = kp[c];
                    s += rdlane(qv, c * 8 + 0) * bflo(kv.x) + rdlane(qv, c * 8 + 1) * bfhi(kv.x);
                    s += rdlane(qv, c * 8 + 2) * bflo(kv.y) + rdlane(qv, c * 8 + 3) * bfhi(kv.y);
                    s += rdlane(qv, c * 8 + 4) * bflo(kv.z) + rdlane(qv, c * 8 + 5) * bfhi(kv.z);
                    s += rdlane(qv, c * 8 + 6) * bflo(kv.w) + rdlane(qv, c * 8 + 7) * bfhi(kv.w);
                }
                s += rel_bias[rel_bucket((tp - t) * dil) * 16 + h];
                s = valid ? s : -INFINITY;
                const float bm = wave_max(s);
                if (bm == -INFINITY) continue;
                const float mn = fmaxf(m, bm);
                const float sc = __expf(m - mn);
                const float pe = valid ? __expf(s - mn) : 0.f;
                l = l * sc + wave_sum(pe);
                o *= sc;
                const int tb = t - R + 64 * b;
                for (int j = 0; j < 64; ++j) {
                    const float pj = rdlane(pe, j);
                    const int tj = min(max(tb + j, 0), L - 1);
                    o += pj * bf2f(base[(size_t)(seqbase + tj * dil + r) * ld + 1280 + g * 64 + lane]);
                }
                m = mn;
            }
        }
        out[(size_t)tok * DM + h * 64 + lane] = f2bf(o / l);
    }
}

__device__ void phase_b_stats(const bf16_t* __restrict__ Z, float2* __restrict__ stats) {
    const int tid = tid_opaque(), lane = tid & 63, gw = blockIdx.x * 8 + (tid >> 6), nw = gridDim.x * 8;
    for (int r = gw; r < CHK; r += nw) {
        const uint4* vp = (const uint4*)(Z + (size_t)r * 4096 + 2048);
        float x[32]; float s = 0.f;
#pragma unroll
        for (int k = 0; k < 4; ++k) { const uint4 w = vp[lane + 64 * k];
            x[k * 8 + 0] = bflo(w.x); x[k * 8 + 1] = bfhi(w.x); x[k * 8 + 2] = bflo(w.y); x[k * 8 + 3] = bfhi(w.y);
            x[k * 8 + 4] = bflo(w.z); x[k * 8 + 5] = bfhi(w.z); x[k * 8 + 6] = bflo(w.w); x[k * 8 + 7] = bfhi(w.w); }
#pragma unroll
        for (int k = 0; k < 32; ++k) s += x[k];
        const float mu = wave_sum(s) * (1.0f / 2048.0f);
        float q = 0.f;
#pragma unroll
        for (int k = 0; k < 32; ++k) { const float d = x[k] - mu; q += d * d; }
        const float var = wave_sum(q) * (1.0f / 2048.0f);
        if (lane == 0) stats[r] = make_float2(mu, 1.0f / sqrtf(var + 1e-5f));
    }
}

__device__ void phase_b_mix_naive(const Params& p, bf16_t* __restrict__ Z, const float2* __restrict__ stats, float* vln  ) {
    const int tid = tid_opaque();
    for (int unit = blockIdx.x; unit < 128 * 16; unit += gridDim.x) {
        const int tc = unit >> 4, cb = unit & 15, g = cb >> 1;
        for (int piece = tid; piece < 2048; piece += 512) {
            const int q = piece >> 4, c8 = (piece & 15) * 8;
            const int tok = tc * 128 + q, ch = cb * 128 + c8;
            const uint4 w = *(const uint4*)(Z + (size_t)tok * 4096 + 2048 + ch);
            const float2 st = stats[tok];
            const float4 g0 = *(const float4*)(p.b_ln_g + ch), g1 = *(const float4*)(p.b_ln_g + ch + 4), b0 = *(const float4*)(p.b_ln_b + ch), b1 = *(const float4*)(p.b_ln_b + ch + 4);
            float* d = vln + q * 128 + c8;
            d[0] = (bflo(w.x) - st.x) * st.y * g0.x + b0.x; d[1] = (bfhi(w.x) - st.x) * st.y * g0.y + b0.y;
            d[2] = (bflo(w.y) - st.x) * st.y * g0.z + b0.z; d[3] = (bfhi(w.y) - st.x) * st.y * g0.w + b0.w;
            d[4] = (bflo(w.z) - st.x) * st.y * g1.x + b1.x; d[5] = (bfhi(w.z) - st.x) * st.y * g1.y + b1.y;
            d[6] = (bflo(w.w) - st.x) * st.y * g1.z + b1.z; d[7] = (bfhi(w.w) - st.x) * st.y * g1.w + b1.w;
        }
        __syncthreads();
        const int ch = tid & 127, pq = tid >> 7;
        for (int pp = 0; pp < 32; pp += 4) {
            const int p0 = pq * 32 + pp;
            const float* w0 = p.b_ws + (size_t)(g * 128 + p0) * 128;
            float a0 = 0.f, a1 = 0.f, a2 = 0.f, a3 = 0.f;
            for (int q = 0; q < 128; ++q) {
                const float v = vln[q * 128 + ch];
                a0 += w0[q] * v; a1 += w0[128 + q] * v; a2 += w0[256 + q] * v; a3 += w0[384 + q] * v;
            }
            const float acc[4] = {a0, a1, a2, a3};
#pragma unroll
            for (int k = 0; k < 4; ++k) {
                const int pr = p0 + k;
                bf16_t* up = Z + (size_t)(tc * 128 + pr) * 4096 + cb * 128 + ch;
                *up = f2bf(bf2f(*up) * (acc[k] + p.b_bs[g * 128 + pr]));
            }
        }
        __syncthreads();
    }
}


typedef float f32x16 __attribute__((ext_vector_type(16)));
typedef short s16x4 __attribute__((ext_vector_type(4)));
__device__ __forceinline__ unsigned lds_off(const LAS void* p) { return (unsigned)(__UINTPTR_TYPE__)p; }
__device__ __forceinline__ bf16x8 tr_read2(unsigned a0, unsigned a1) {
    s16x4 r0, r1;
    asm volatile("ds_read_b64_tr_b16 %0, %2\n\tds_read_b64_tr_b16 %1, %3\n\ts_waitcnt lgkmcnt(0)" : "=&v"(r0), "=&v"(r1) : "v"(a0), "v"(a1) : "memory");
    bf16x8 r; r[0] = r0[0]; r[1] = r0[1]; r[2] = r0[2]; r[3] = r0[3]; r[4] = r1[0]; r[5] = r1[1]; r[6] = r1[2]; r[7] = r1[3]; return r;
}
constexpr int AT_KS = 144, AT_VS = 192, AT_BT = 324, AT_NKMAX = 384;
#define TR_ISSUE8(va, a0, a1, b0, b1, c0, c1, d0, d1) \
    asm volatile("ds_read_b64_tr_b16 %0, %8\n\tds_read_b64_tr_b16 %1, %8 offset:1536\n\tds_read_b64_tr_b16 %2, %8 offset:64\n\tds_read_b64_tr_b16 %3, %8 offset:1600\n\t" \
                 "ds_read_b64_tr_b16 %4, %8 offset:3072\n\tds_read_b64_tr_b16 %5, %8 offset:4608\n\tds_read_b64_tr_b16 %6, %8 offset:3136\n\tds_read_b64_tr_b16 %7, %8 offset:4672" \
                 : "=&v"(a0), "=&v"(a1), "=&v"(b0), "=&v"(b1), "=&v"(c0), "=&v"(c1), "=&v"(d0), "=&v"(d1) : "v"(va))
#define TR_WAIT8(a0, a1, b0, b1, c0, c1, d0, d1) \
    asm volatile("s_waitcnt lgkmcnt(0)" : "+v"(a0), "+v"(a1), "+v"(b0), "+v"(b1), "+v"(c0), "+v"(c1), "+v"(d0), "+v"(d1))
__device__ __forceinline__ bf16x8 cat4(s16x4 lo, s16x4 hi) { bf16x8 r; r[0] = lo[0]; r[1] = lo[1]; r[2] = lo[2]; r[3] = lo[3]; r[4] = hi[0]; r[5] = hi[1]; r[6] = hi[2]; r[7] = hi[3]; return r; }
static_assert(AT_NKMAX * (AT_KS + AT_VS) <= 131072 && 4 * AT_BT * 4 <= 16384, "attention LDS map");
static_assert(AT_VS == 192, "tr_read8 immediates: 8 rows = 1536 B, 16 rows = 3072 B, 24 rows = 4608 B");
__device__ __forceinline__ void phase_attn(const bf16_t* __restrict__ qkv, int ld, bool isC, const float* __restrict__ rel_bias, const float* __restrict__ sink,
                           bf16_t* __restrict__ out, bf16_t* __restrict__ out12, float* __restrict__ lse, LAS unsigned char* lds) {
    const int tid = tid_opaque(), lane = tid & 63, wid = __builtin_amdgcn_readfirstlane(tid >> 6), n = lane & 31, hf = lane >> 5;
    const int R = isC ? 64 : 128, NK = 128 + 2 * R, NT = R / 16 + 1;
    LAS unsigned char* Ks = lds; LAS unsigned char* Vs = lds + AT_NKMAX * AT_KS; LAS float* bT = (LAS float*)(lds + 131072 + 16 + 4096);
    const float L2E = 1.4426950408889634f;
    const int hl = wid >> 1, sb2 = wid & 1;
    int bias_key = -1;
    const int cw = ((gridDim.x & 7) == 0) ? (int)((blockIdx.x & 7) * (gridDim.x >> 3) + (blockIdx.x >> 3)) : (int)blockIdx.x;
    const bool cmap = gridDim.x == 256;
    const int nit = cmap ? 6 : (1536 - cw + (int)gridDim.x - 1) / (int)gridDim.x;
    for (int itu = 0; itu < nit; ++itu) {
        int u = cw + itu * (int)gridDim.x;
        if (cmap) { const int x = (int)(blockIdx.x & 7), rw = (int)(blockIdx.x >> 3), gq = rw >> 3, idx = (rw & 7) + 8 * itu;
            u = isC ? ((idx >> 4) * 512 + x * 64 + gq * 16 + (idx & 15)) : ((3 * x + (idx >> 4)) * 64 + gq * 16 + (idx & 15)); }
        int gi = 0, dil = 1, seq, g, r = 0, tb;
        if (isC) { gi = u >> 9; const int rem = u & 511; seq = rem >> 6; g = (rem >> 4) & 3; const int rb = rem & 15; dil = gi == 0 ? 1 : (gi == 1 ? 4 : 16); r = rb & (dil - 1); tb = rb / dil; }
        else { seq = u >> 6; g = (u >> 4) & 3; tb = u & 15; }
        const int L = SEQ / dil, t0 = tb * 128;
        const bf16_t* base = qkv + (size_t)gi * 1536;
        const size_t seqbase = (size_t)seq * SEQ;
        __syncthreads();
        {
            u32x4 kreg[6], vreg[6];
#pragma unroll
            for (int it = 0; it < 6; ++it) {
                const int idx = tid + 512 * it, row = idx >> 3, pc = idx & 7, tp = t0 - R + row;
                kreg[it] = (u32x4){0u, 0u, 0u, 0u}; vreg[it] = kreg[it];
                if (idx < NK * 8 && tp >= 0 && tp < L) { const bf16_t* src = base + (seqbase + (size_t)tp * dil + r) * ld + 1024 + g * 64 + pc * 8; kreg[it] = *(const u32x4*)src; vreg[it] = *(const u32x4*)(src + 256); }
            }
#pragma unroll
            for (int it = 0; it < 6; ++it) {
                const int idx = tid + 512 * it, row = idx >> 3, pc = idx & 7;
                if (idx < NK * 8) { *(LAS u32x4*)(Ks + row * AT_KS + pc * 16) = kreg[it]; *(LAS u32x4*)(Vs + row * AT_VS + pc * 16) = vreg[it]; }
            }
        }
        if (bias_key != gi * 4 + g) {
            bias_key = gi * 4 + g;
            for (int idx = tid; idx < 4 * AT_BT; idx += 512) {
                const int h4 = idx / AT_BT, rel = idx - h4 * AT_BT - 32;
                float v = -INFINITY;
                if (rel >= 0 && rel <= 2 * R) v = rel_bias[rel_bucket((rel - R) * dil) * 16 + g * 4 + h4] * L2E;
                bT[idx] = v;
            }
        }
        __syncthreads();
        const int hh = g * 4 + hl;
        const unsigned vlane = lds_off(Vs) + (unsigned)((4 * hf + ((lane & 15) >> 2)) * AT_VS + (16 * ((lane >> 4) & 1) + 4 * (lane & 3)) * 2);
        for (int j = 0; j < 2; ++j) {
            const int qb = sb2 * 2 + j;
            const int tq = t0 + 32 * qb + n;
            const size_t qtok = seqbase + (size_t)tq * dil + r;
            const bf16_t* qp = base + qtok * ld + hh * 64 + 8 * hf;
            bf16x8 qf[4];
#pragma unroll
            for (int ks = 0; ks < 4; ++ks) qf[ks] = *(const bf16x8*)(qp + 16 * ks);
            f32x16 o0, o1;
#pragma unroll
            for (int i = 0; i < 16; ++i) { o0[i] = 0.f; o1[i] = 0.f; }
            float m = -INFINITY, l = 0.f;
            if (sink) { m = sink[hh] * L2E; l = hf == 0 ? 1.f : 0.f; }
            const LAS float* bp = bT + hl * AT_BT + 32 - n + 4 * hf;
            const int tbase = t0 + 32 * qb - R;
            const int kt_lo = tbase < 0 ? (-tbase) >> 5 : 0, kt_hi = min(NT - 1, (L - 32 - tbase) >> 5);
            f32x16 sn;
            {
#pragma unroll
                for (int i = 0; i < 16; ++i) sn[i] = 0.f;
                const LAS unsigned char* kr = Ks + (32 * qb + 32 * kt_lo + n) * AT_KS + 16 * hf;
#pragma unroll
                for (int ks = 0; ks < 4; ++ks) sn = __builtin_amdgcn_mfma_f32_32x32x16_bf16(*(const LAS bf16x8*)(kr + 32 * ks), qf[ks], sn, 0, 0, 0);
            }
            for (int kt = kt_lo; kt <= kt_hi; ++kt) {
                const int rowb = 32 * qb + 32 * kt;
                f32x16 s = sn;
                s16x4 ta0, ta1, tb0, tb1, tc0, tc1, td0, td1;
                { const unsigned va = vlane + (unsigned)(rowb * AT_VS); TR_ISSUE8(va, ta0, ta1, tb0, tb1, tc0, tc1, td0, td1); }
                {
                    const int ktn = min(kt + 1, kt_hi);
#pragma unroll
                    for (int i = 0; i < 16; ++i) sn[i] = 0.f;
                    const LAS unsigned char* kr = Ks + (32 * qb + 32 * ktn + n) * AT_KS + 16 * hf;
#pragma unroll
                    for (int ks = 0; ks < 4; ++ks) sn = __builtin_amdgcn_mfma_f32_32x32x16_bf16(*(const LAS bf16x8*)(kr + 32 * ks), qf[ks], sn, 0, 0, 0);
                }
                float mx = -INFINITY;
                {
                    const f32x2 c2 = (f32x2){0.125f * L2E, 0.125f * L2E};
#pragma unroll
                    for (int k = 0; k < 8; ++k) { const int i = 2 * k; const LAS float* bq = bp + 32 * kt + (i & 3) + 8 * (i >> 2);
                        f32x2 v = (f32x2){s[i], s[i + 1]} * c2 + (f32x2){bq[0], bq[1]}; s[i] = v.x; s[i + 1] = v.y; }
#pragma unroll
                    for (int i = 0; i < 16; ++i) mx = fmaxf(mx, s[i]);
                }
                mx = fmaxf(mx, __shfl_xor(mx, 32, 64));
                const float mn = fmaxf(m, mx);
                if (__any(mn > m + 8.0f)) {
                    const float sc = __builtin_amdgcn_exp2f(m - mn);
                    l *= sc;
#pragma unroll
                    for (int i = 0; i < 16; ++i) { o0[i] *= sc; o1[i] *= sc; }
                    m = mn;
                }
                {
                    const f32x2 m2 = (f32x2){m, m}; f32x2 ps2 = (f32x2){0.f, 0.f};
#pragma unroll
                    for (int k = 0; k < 8; ++k) { const int i = 2 * k; f32x2 v = (f32x2){s[i], s[i + 1]} - m2; v.x = __builtin_amdgcn_exp2f(v.x); v.y = __builtin_amdgcn_exp2f(v.y); ps2 += v; s[i] = v.x; s[i + 1] = v.y; }
                    l += ps2.x + ps2.y;
                }
                union { bf16x8 v; unsigned w[4]; } pf0, pf1;
#pragma unroll
                for (int jj = 0; jj < 4; ++jj) { pf0.w[jj] = pg8::cvt_pk_bf16(s[2 * jj], s[2 * jj + 1]); pf1.w[jj] = pg8::cvt_pk_bf16(s[8 + 2 * jj], s[8 + 2 * jj + 1]); }
                TR_WAIT8(ta0, ta1, tb0, tb1, tc0, tc1, td0, td1);
                o0 = __builtin_amdgcn_mfma_f32_32x32x16_bf16(cat4(ta0, ta1), pf0.v, o0, 0, 0, 0);
                o1 = __builtin_amdgcn_mfma_f32_32x32x16_bf16(cat4(tb0, tb1), pf0.v, o1, 0, 0, 0);
                o0 = __builtin_amdgcn_mfma_f32_32x32x16_bf16(cat4(tc0, tc1), pf1.v, o0, 0, 0, 0);
                o1 = __builtin_amdgcn_mfma_f32_32x32x16_bf16(cat4(td0, td1), pf1.v, o1, 0, 0, 0);
            }
            l += __shfl_xor(l, 32, 64);
            const float inv = 1.0f / l;
            bf16_t* op = (gi == 0 ? out : out12 + (size_t)(gi - 1) * CHK * 1024) + qtok * 1024 + hh * 64 + 4 * hf;
#pragma unroll
            for (int gq = 0; gq < 4; ++gq) {
                uint2 w0, w1;
                w0.x = pg8::cvt_pk_bf16(o0[4 * gq] * inv, o0[4 * gq + 1] * inv); w0.y = pg8::cvt_pk_bf16(o0[4 * gq + 2] * inv, o0[4 * gq + 3] * inv);
                w1.x = pg8::cvt_pk_bf16(o1[4 * gq] * inv, o1[4 * gq + 1] * inv); w1.y = pg8::cvt_pk_bf16(o1[4 * gq + 2] * inv, o1[4 * gq + 3] * inv);
                *(uint2*)(op + 8 * gq) = w0; *(uint2*)(op + 32 + 8 * gq) = w1;
            }
            if (isC && hf == 0) lse[((size_t)gi * CHK + qtok) * 16 + hh] = (m + __log2f(l)) * 0.6931471805599453f;
        }
    }
}

__device__ void phase_c_merge(const bf16_t* __restrict__ OG, const float* __restrict__ LSE, bf16_t* Hc) {
    const int tid = tid_opaque();
    const bool cmap = gridDim.x == 256;
    const int i0 = cmap ? (int)(blockIdx.x & 7) * 262144 + (int)(blockIdx.x >> 3) * 512 + tid : (int)blockIdx.x * 512 + tid;
    const int iend = cmap ? (int)(blockIdx.x & 7) * 262144 + 262144 : CHK * 128, istep = cmap ? 16384 : (int)gridDim.x * 512;
    for (int idx = i0; idx < iend; idx += istep) {
        const int tok = idx >> 7, c8 = (idx & 127) * 8, h = c8 >> 6;
        const float l0 = LSE[(size_t)tok * 16 + h], l1 = LSE[((size_t)CHK + tok) * 16 + h], l2 = LSE[((size_t)2 * CHK + tok) * 16 + h];
        const float mx = fmaxf(l0, fmaxf(l1, l2));
        float w0 = __expf(l0 - mx), w1 = __expf(l1 - mx), w2 = __expf(l2 - mx);
        const float inv = 1.0f / (w0 + w1 + w2); w0 *= inv; w1 *= inv; w2 *= inv;
        const uint4 a = *(const uint4*)(Hc + (size_t)tok * 1024 + c8), b = *(const uint4*)(OG + (size_t)tok * 1024 + c8), c = *(const uint4*)(OG + ((size_t)CHK + tok) * 1024 + c8);
        uint4 o;
        o.x = pack2(w0 * bflo(a.x) + w1 * bflo(b.x) + w2 * bflo(c.x), w0 * bfhi(a.x) + w1 * bfhi(b.x) + w2 * bfhi(c.x));
        o.y = pack2(w0 * bflo(a.y) + w1 * bflo(b.y) + w2 * bflo(c.y), w0 * bfhi(a.y) + w1 * bfhi(b.y) + w2 * bfhi(c.y));
        o.z = pack2(w0 * bflo(a.z) + w1 * bflo(b.z) + w2 * bflo(c.z), w0 * bfhi(a.z) + w1 * bfhi(b.z) + w2 * bfhi(c.z));
        o.w = pack2(w0 * bflo(a.w) + w1 * bflo(b.w) + w2 * bflo(c.w), w0 * bfhi(a.w) + w1 * bfhi(b.w) + w2 * bfhi(c.w));
        *(uint4*)(Hc + (size_t)tok * 1024 + c8) = o;
    }
}

constexpr int BM_VS = 576, BM_WS = 272;
__device__ void phase_b_mix(const Params& p, const bf16_t* __restrict__ Z, bf16_t* __restrict__ Gt, const float2* __restrict__ stats, const bf16_t* __restrict__ WsB, LAS unsigned char* lds) {
    const int tid = tid_opaque(), lane = tid & 63, wid = __builtin_amdgcn_readfirstlane(tid >> 6), n = lane & 31, hf = lane >> 5;
    LAS unsigned char* Vl = lds; LAS unsigned char* Wl = lds + 128 * BM_VS; LAS float* stl = (LAS float*)(lds + 128 * BM_VS + 128 * BM_WS);
    const bool rmap = gridDim.x == 256;
    for (int unit = blockIdx.x; unit < 128 * 8; unit += gridDim.x) {
        int tc = unit >> 3, g = unit & 7;
        if (rmap) { const int idx = (int)(blockIdx.x >> 3) + 32 * (unit >> 8); tc = 16 * (int)(blockIdx.x & 7) + (idx >> 3); g = idx & 7; }
        __syncthreads();
        if (tid < 128) {
            const f32x4* sp = (const f32x4*)(stats + (size_t)(tc * 128 + tid) * 8);
            const f32x4 a = sp[0], b = sp[1], c = sp[2], d = sp[3];
            const float S1 = ((a[0] + a[2]) + (b[0] + b[2])) + ((c[0] + c[2]) + (d[0] + d[2])), S2 = ((a[1] + a[3]) + (b[1] + b[3])) + ((c[1] + c[3]) + (d[1] + d[3]));
            const float mu = S1 * (1.0f / 2048.0f), var = fmaxf(S2 * (1.0f / 2048.0f) - mu * mu, 0.f);
            stl[2 * tid] = mu; stl[2 * tid + 1] = 1.0f / sqrtf(var + 1e-5f);
        }
        for (int piece = tid; piece < 2048; piece += 512) {
            const int pr = piece >> 4, c8 = (piece & 15) * 8;
            *(LAS u32x4*)(Wl + pr * BM_WS + c8 * 2) = *(const u32x4*)(WsB + (size_t)(g * 128 + pr) * 128 + c8);
        }
        __syncthreads();
        {
            const int c8 = (tid & 31) * 8, ch = g * 256 + c8;
            const float4 g0 = *(const float4*)(p.b_ln_g + ch), g1 = *(const float4*)(p.b_ln_g + ch + 4), b0 = *(const float4*)(p.b_ln_b + ch), b1 = *(const float4*)(p.b_ln_b + ch + 4);
            uint4 wv[8];
#pragma unroll
            for (int it = 0; it < 8; ++it) { const int q = (tid >> 5) + 16 * it; wv[it] = *(const uint4*)(Z + (size_t)(tc * 128 + q) * 4096 + 2048 + ch); }
#pragma unroll
            for (int it = 0; it < 8; ++it) {
                const int q = (tid >> 5) + 16 * it; const uint4 w = wv[it];
                const float2 st = make_float2(stl[2 * q], stl[2 * q + 1]);
                u32x4 o;
                o.x = pack2((bflo(w.x) - st.x) * st.y * g0.x + b0.x, (bfhi(w.x) - st.x) * st.y * g0.y + b0.y);
                o.y = pack2((bflo(w.y) - st.x) * st.y * g0.z + b0.z, (bfhi(w.y) - st.x) * st.y * g0.w + b0.w);
                o.z = pack2((bflo(w.z) - st.x) * st.y * g1.x + b1.x, (bfhi(w.z) - st.x) * st.y * g1.y + b1.y);
                o.w = pack2((bflo(w.w) - st.x) * st.y * g1.z + b1.z, (bfhi(w.w) - st.x) * st.y * g1.w + b1.w);
                *(LAS u32x4*)(Vl + q * BM_VS + c8 * 2) = o;
            }
        }
        __syncthreads();
        f32x16 acc[4];
#pragma unroll
        for (int pt = 0; pt < 4; ++pt)
#pragma unroll
            for (int i = 0; i < 16; ++i) acc[pt][i] = 0.f;
        const unsigned va = lds_off(Vl) + (unsigned)((8 * hf + ((lane & 15) >> 2)) * BM_VS + (32 * wid + 16 * ((lane >> 4) & 1) + 4 * (lane & 3)) * 2);
        const LAS unsigned char* wb = Wl + n * BM_WS + 16 * hf;
#pragma unroll 2
        for (int ks = 0; ks < 8; ++ks) {
            const bf16x8 af = tr_read2(va + (unsigned)(16 * ks * BM_VS), va + (unsigned)((16 * ks + 4) * BM_VS));
#pragma unroll
            for (int pt = 0; pt < 4; ++pt) { const bf16x8 bf = *(const LAS bf16x8*)(wb + pt * 32 * BM_WS + 32 * ks); acc[pt] = __builtin_amdgcn_mfma_f32_32x32x16_bf16(af, bf, acc[pt], 0, 0, 0); }
        }
#pragma unroll
        for (int pt = 0; pt < 4; ++pt) {
            const int pr = 32 * pt + n;
            const float bs = p.b_bs[g * 128 + pr];
            const bf16_t* up = Z + (size_t)(tc * 128 + pr) * 4096 + g * 256 + 32 * wid + 4 * hf;
            bf16_t* gp = Gt + (size_t)(tc * 128 + pr) * 2048 + g * 256 + 32 * wid + 4 * hf;
#pragma unroll
            for (int gq = 0; gq < 4; ++gq) {
                const uint2 uw = *(const uint2*)(up + 8 * gq);
                uint2 o;
                o.x = pg8::cvt_pk_bf16(bflo(uw.x) * (acc[pt][4 * gq] + bs), bfhi(uw.x) * (acc[pt][4 * gq + 1] + bs));
                o.y = pg8::cvt_pk_bf16(bflo(uw.y) * (acc[pt][4 * gq + 2] + bs), bfhi(uw.y) * (acc[pt][4 * gq + 3] + bs));
                *(uint2*)(gp + 8 * gq) = o;
            }
        }
    }
}

struct Prog { unsigned v[192]; int n; };
constexpr Prog make_prog() {
    Prog P{}; int n = 0;
    auto add = [&](int type, int layer, int chunk) { const int reps = 1 + (type == PROBE_TYPE ? PROBE_REP : 0); for (int q = 0; q < reps; ++q) P.v[n++] = (unsigned)type | ((unsigned)layer << 8) | ((unsigned)chunk << 16) | (q + 1 < reps ? (1u << 24) : 0u); };
    add(PH_PREP, 0, 0);
    if (PROBE_TYPE == 99) for (int q = 0; q < PROBE_REP; ++q) P.v[n++] = 99u;
    for (int i = 0; i < 4; ++i) {
        const int kind = i % 3;
        if (kind == 0) { add(PH_A_QKV, i, 0); add(PH_A_ATTN, i, 0); add(PH_A_WO, i, 0); }
        else if (kind == 1) { for (int c = 0; c < NCHK; ++c) { add(PH_B_IN, i, c); add(PH_B_MIX, i, c); add(PH_B_OUT, i, c); } }
        else { for (int c = 0; c < NCHK; ++c) { add(PH_C_QKV, i, c); add(PH_C_ATTN, i, c); add(PH_C_MERGE, i, c); } add(PH_C_WO, i, 0); }
        for (int c = 0; c < NCHK; ++c) { add(PH_FFN1, i, c); add(PH_FFN2, i, c); }
    }
    add(PH_FINAL, 0, 0);
    P.n = n; return P;
}
constexpr Prog h_prog = make_prog();
__device__ const Prog d_prog = make_prog();

__global__ void __launch_bounds__(512, 2) mega(Params p, int pb, int pe) {
    extern __shared__ __attribute__((aligned(16))) unsigned char shm[];
    cg::grid_group grid = cg::this_grid();
    bf16_t* const Wt = (bf16_t*)(p.ws + WS_WT);
    bf16_t* const H = (bf16_t*)(p.ws + WS_H);
    bf16_t* const Pb = (bf16_t*)(p.ws + WS_P);
    float* const ssq0 = (float*)(p.ws + WS_S + S_SSQ0);
    float* const ssq1 = (float*)(p.ws + WS_S + S_SSQ1);
    unsigned char* const S = p.ws + WS_S;
    volatile LAS unsigned* st = (volatile LAS unsigned*)((LAS unsigned char*)shm + 131072);
    unsigned* const bar = (unsigned*)(p.ws + WS_BAR);
    if (pe - pb > 1) {
        if (blockIdx.x == 0) for (int i = threadIdx.x; i < XCD_BAR_WORDS; i += 512) bar[i] = 0u;
        if (threadIdx.x < 4) st[threadIdx.x] = 0u;
    }
    XcdBarrier xb; xb.bar = bar; xb.x = 0u; xb.st = st;
    for (int ph = pb; ph < pe; ++ph) {
        if (ph == pb + 1) { grid.sync(); xb = xcd_barrier_post(bar, st); }
        else if (ph > pb + 1) { const unsigned cd = d_prog.v[ph]; const int ty = cd & 0xff, ck = (cd >> 16) & 0xff, ly = (cd >> 8) & 0xff;
            if (__builtin_amdgcn_readfirstlane((int)st[3]) == 1 && (ty == PH_FFN2 || (ty == PH_FFN1 && (ck > 0 || ly == 1 || ly == 2)) || ty == PH_B_MIX || ty == PH_B_OUT || ty == PH_B_IN ||
                 ty == PH_A_ATTN || ty == PH_A_WO || ty == PH_C_ATTN || ty == PH_C_MERGE || (ty == PH_C_QKV && ck > 0))) xcd_local_barrier(xb); else xcd_barrier(xb); }
        const unsigned code = d_prog.v[ph];
        const int type = code & 0xff, layer = (code >> 8) & 0xff, chunk = (code >> 16) & 0xff;
        pg8::Gemm g; g.A = nullptr; g.Bt = nullptr; g.M = 0; g.N = 0; g.K = 0; g.lda = 0;
        void* outp = nullptr; int ldc = 0, epi = -1;
        const size_t crow = (size_t)chunk * CHK;
        const float* rssq = nullptr; float* wssq = nullptr; float* zssq = nullptr;
        switch (type) {
            case PH_A_QKV: g.A = Pb; g.lda = 1024; g.Bt = Wt + OFF_AQKV + (size_t)(layer / 3) * 1572864; g.M = T_TOK; g.N = 1536; g.K = 1024; outp = S; ldc = 1536; epi = 0; rssq = ssq0; break;
            case PH_A_WO:  g.A = H; g.lda = 1024; g.Bt = Wt + OFF_AWO + (size_t)(layer / 3) * 1048576; g.M = T_TOK; g.N = 1024; g.K = 1024; epi = 3; wssq = ssq1; break;
            case PH_FFN1:  g.A = Pb + crow * 1024; g.lda = 1024; g.Bt = Wt + OFF_W1 + (size_t)layer * 4194304; g.M = CHK; g.N = 4096; g.K = 1024; outp = S; ldc = 4096; epi = 2; rssq = ssq1 + crow * 4; break;
            case PH_FFN2:  g.A = (const bf16_t*)S; g.lda = 4096; g.Bt = Wt + OFF_W2 + (size_t)layer * 4194304; g.M = CHK; g.N = 1024; g.K = 4096; epi = 3; wssq = ssq0; break;
            case PH_B_IN:  g.A = Pb + crow * 1024; g.lda = 1024; g.Bt = Wt + OFF_BWIN; g.M = CHK; g.N = 4096; g.K = 1024; outp = S; ldc = 4096; epi = 1; rssq = ssq0 + crow * 4; break;
            case PH_B_OUT: g.A = (const bf16_t*)(S + S_GATE); g.lda = 2048; g.Bt = Wt + OFF_BWO; g.M = CHK; g.N = 1024; g.K = 2048; epi = 3; wssq = ssq1; break;
            case PH_C_QKV: g.A = Pb + crow * 1024; g.lda = 1024; g.Bt = Wt + OFF_CQKV; g.M = CHK; g.N = 4608; g.K = 1024; outp = S; ldc = 4608; epi = 0; rssq = ssq0 + crow * 4; break;
            case PH_C_WO:  g.A = H; g.lda = 1024; g.Bt = Wt + OFF_CWO; g.M = T_TOK; g.N = 1024; g.K = 1024; epi = 3; wssq = ssq1; break;
            default: break;
        }
        if (epi >= 0) {
            if (zssq) zero_f32(zssq, T_TOK);
            const size_t xrow = (g.M == CHK) ? crow : 0;
            pg8::StaticOrder so; so.init(g.M, g.N, (int)gridDim.x, (int)blockIdx.x, type == PH_C_WO);
            if (epi == 0) { pg8::EpiBf16<0> E; E.O = (bf16_t*)outp; E.ldc = ldc; E.ssq = rssq; E.stat = nullptr; E.red2 = nullptr; E.rsl = (LAS float*)((LAS unsigned char*)shm + 131072 + 16 + 4096); pg8::gemm_phase((LAS unsigned char*)shm, g, so, E); }
            else if (epi == 1) { pg8::EpiBf16<1> E; E.O = (bf16_t*)outp; E.ldc = ldc; E.ssq = rssq; E.rsl = (LAS float*)((LAS unsigned char*)shm + 131072 + 16 + 4096); E.stat = (float2*)(S + S_STATS); E.red2 = (LAS float*)((LAS unsigned char*)shm + 131072 + 16 + 4096 + 16384); pg8::gemm_phase((LAS unsigned char*)shm, g, so, E); }
            else if (epi == 2) { pg8::EpiBf16<2> E; E.O = (bf16_t*)outp; E.ldc = ldc; E.ssq = rssq; E.stat = nullptr; E.red2 = nullptr; E.rsl = (LAS float*)((LAS unsigned char*)shm + 131072 + 16 + 4096); pg8::gemm_phase((LAS unsigned char*)shm, g, so, E); }
            else { pg8::EpiRes E; E.Cb = Pb + xrow * 1024; E.ssq = wssq + xrow * 4; E.red = (LAS float*)((LAS unsigned char*)shm + 131072 + 16); pg8::gemm_phase((LAS unsigned char*)shm, g, so, E); }
            continue;
        }
        switch (type) {
            case PH_PREP: {
                float* tile = (float*)shm;
                for (int i = 0; i < 4; ++i) convert_T(p.ffn_w1 + (size_t)i * 4194304, Wt + OFF_W1 + (size_t)i * 4194304, 1024, 4096, tile, p.norm_ffn_g + i * DM);
                for (int i = 0; i < 4; ++i) convert_T(p.ffn_w2 + (size_t)i * 4194304, Wt + OFF_W2 + (size_t)i * 4194304, 4096, 1024, tile);
                for (int j = 0; j < 2; ++j) convert_T(p.a_wqkv + (size_t)j * 1572864, Wt + OFF_AQKV + (size_t)j * 1572864, 1024, 1536, tile, p.norm_mix_g + (3 * j) * DM);
                for (int j = 0; j < 2; ++j) convert_T(p.a_wo + (size_t)j * 1048576, Wt + OFF_AWO + (size_t)j * 1048576, 1024, 1024, tile);
                convert_T(p.b_win, Wt + OFF_BWIN, 1024, 4096, tile, p.norm_mix_g + 1 * DM);
                convert_T(p.b_wo, Wt + OFF_BWO, 2048, 1024, tile);
                convert_T(p.c_wqkv, Wt + OFF_CQKV, 1024, 4608, tile, p.norm_mix_g + 2 * DM);
                convert_T(p.c_wo, Wt + OFF_CWO, 1024, 1024, tile);
                for (int i = blockIdx.x * 512 + tid_opaque(); i < 131072; i += gridDim.x * 512) Wt[OFF_BWS + i] = f2bf(p.b_ws[i]);
                phase_prep_x(p, Pb, ssq0);
            } break;
            case PH_FINAL:    phase_final(Pb, p.final_g, p.X); break;
#if NAIVE_ATTN
            case PH_A_ATTN:   phase_attn_naive((const bf16_t*)S, 1536, 1, p.rel_bias, p.a_sink + (layer / 3) * 16, H, T_TOK); break;
            case PH_C_ATTN:   phase_attn_naive((const bf16_t*)S, 4608, 3, p.rel_bias, nullptr, H + crow * 1024, CHK); break;
#else
            case PH_A_ATTN: case PH_C_ATTN: {
                const bool isC = type == PH_C_ATTN;
                phase_attn((const bf16_t*)S, isC ? 4608 : 1536, isC, p.rel_bias, isC ? nullptr : p.a_sink + (layer / 3) * 16, isC ? H + crow * 1024 : H,
                           isC ? (bf16_t*)(S + S_OG) : nullptr, isC ? (float*)(S + S_LSE) : nullptr, (LAS unsigned char*)shm);
            } break;
            case PH_C_MERGE:  phase_c_merge((const bf16_t*)(S + S_OG), (const float*)(S + S_LSE), H + crow * 1024); break;
#endif
            case PH_B_STATS:  phase_b_stats((const bf16_t*)S, (float2*)(S + S_STATS)); break;
#if NAIVE_MIX
            case PH_B_MIX:    phase_b_mix_naive(p, (bf16_t*)S, (const float2*)(S + S_STATS), (float*)shm); break;
#else
            case PH_B_MIX:    phase_b_mix(p, (const bf16_t*)S, (bf16_t*)(S + S_GATE), (const float2*)(S + S_STATS), Wt + OFF_BWS, (LAS unsigned char*)shm); break;
#endif
            default: break;
        }
    }
}

extern "C" void kernel_launch(void* const* d_in, const int* in_sizes, int n_in, void* d_out, int out_size, void* d_ws, size_t ws_size, hipStream_t stream) {
    if (n_in != 19 || out_size != T_TOK * DM || ws_size < WS_NEED) { fprintf(stderr, "kernel_launch: unexpected sizes n_in %d out %d ws %zu\n", n_in, out_size, ws_size); return; }
    Params p; memset(&p, 0, sizeof(p));
    const float** f = (const float**)&p;
    for (int i = 0; i < 19; ++i) f[i] = (const float*)d_in[i];
    p.X = (float*)d_out; p.ws = (unsigned char*)d_ws;
    static int grid = 0;
    if (!grid) {
        int dev = 0, cus = 0, per_cu = 0;
        hipGetDevice(&dev); hipDeviceGetAttribute(&cus, hipDeviceAttributeMultiprocessorCount, dev);
        hipFuncSetAttribute((const void*)mega, hipFuncAttributeMaxDynamicSharedMemorySize, LDS_BYTES);
        hipOccupancyMaxActiveBlocksPerMultiprocessor(&per_cu, (const void*)mega, 512, LDS_BYTES);
        if (per_cu < 1) { fprintf(stderr, "kernel_launch: occupancy query says %d blocks per CU\n", per_cu); per_cu = 1; }
        grid = cus * per_cu;
        (void)hipGetLastError();
    }
#if ONE_LAUNCH
    int pb = 0, pe = h_prog.n;
    void* args[] = {&p, &pb, &pe};
    hipError_t e = hipLaunchCooperativeKernel((const void*)mega, dim3(grid), dim3(512), args, LDS_BYTES, stream);
    if (e != hipSuccess) fprintf(stderr, "cooperative launch failed: %s (grid %d)\n", hipGetErrorString(e), grid);
#else
    for (int ph = 0; ph < h_prog.n; ++ph) hipLaunchKernelGGL(mega, dim3(grid), dim3(512), LDS_BYTES, stream, p, ph, ph + 1);
#endif
}
```
